# Optimizing an MI355X kernel written in HIP

```python
import math
import jax, jax.numpy as jnp
from jax import lax
import numpy as np

D_MODEL = 1024
BATCH = 4
SEQ = 4096
DEPTH = 4

CHUNK = 64
Q_BLOCK = 128
EPS = 1e-5
CONV_K = 4
D_MIX = D_MODEL
D_FF = 2816

DA_HEADS = 4
DA_QK = D_MODEL // 32
DA_V = 2 * DA_QK
DA_ROT = DA_QK // 4
ROPE_THETA = 500000.0
M_HEADS = 8
M_HEADDIM = 64
M_INNER = M_HEADS * M_HEADDIM
M_GROUPS = 2
M_STATE = 128
G_HEADS = 4
G_DK = 64
G_DV = 64

ALPHA = (2.0 * DEPTH) ** 0.25
BETA_INIT = (8.0 * DEPTH) ** -0.25

IN_SIZES = (DA_HEADS * 2 * DA_QK, DA_HEADS * 2 * DA_QK, DA_HEADS * DA_V,
            M_INNER, M_INNER + 2 * M_GROUPS * M_STATE, M_HEADS,
            G_HEADS * G_DK, G_HEADS * G_DK, G_HEADS * G_DV, G_HEADS * G_DV, G_HEADS, G_HEADS)
D_IN = sum(IN_SIZES)
IN_SPLITS = tuple(int(s) for s in np.cumsum(IN_SIZES)[:-1])

kernel_name = 'chunk_causal_hybrid_head_groups'


def layer_norm(x, g, b):
    xf = x.astype(jnp.float32)
    mu = jnp.mean(xf, -1, keepdims=True)
    var = jnp.mean(jnp.square(xf - mu), -1, keepdims=True)
    return ((xf - mu) * lax.rsqrt(var + EPS) * g + b).astype(x.dtype)


def rms_norm(x, w):
    xf = x.astype(jnp.float32)
    return xf * lax.rsqrt(jnp.mean(xf * xf, -1, keepdims=True) + EPS) * w


def l2_normalize(x):
    return x * lax.rsqrt(jnp.sum(x * x, -1, keepdims=True) + 1e-6)


def swiglu(x, w_gu, w_down):
    gate, up = jnp.split(x @ w_gu, 2, axis=-1)
    return (jax.nn.silu(gate) * up) @ w_down


def causal_dwconv(x, w):
    c = x.shape[-1]
    return lax.conv_general_dilated(
        x, w[:, None, :].astype(x.dtype), window_strides=(1,), padding=[(CONV_K - 1, 0)],
        dimension_numbers=('NWC', 'WIO', 'NWC'), feature_group_count=c)


def lambda_init(layer_idx):
    return 0.8 - 0.6 * math.exp(-0.3 * layer_idx)


def rope_tables(seq_len):
    pos = jnp.arange(seq_len, dtype=jnp.float32)
    inv_freq = ROPE_THETA ** (-jnp.arange(0, DA_ROT, 2, dtype=jnp.float32) / DA_ROT)
    ang = pos[:, None] * inv_freq[None, :]
    return jnp.cos(ang), jnp.sin(ang)


def apply_partial_rotary(t, cos, sin):
    half = DA_ROT // 2
    c = cos[None, :, None, None, :]
    s = sin[None, :, None, None, :]
    tf = t.astype(jnp.float32)
    t1, t2, rest = tf[..., :half], tf[..., half:DA_ROT], tf[..., DA_ROT:]
    return jnp.concatenate([t1 * c - t2 * s, t2 * c + t1 * s, rest], -1).astype(t.dtype)


def diff_attention_mixer(dq, dk, dv, cos, sin, lam_params, subln_w, lam_init):
    bsz, s_len, _ = dq.shape
    q = apply_partial_rotary(dq.reshape(bsz, s_len, DA_HEADS, 2, DA_QK), cos, sin)
    k = apply_partial_rotary(dk.reshape(bsz, s_len, DA_HEADS, 2, DA_QK), cos, sin)
    v = dv.reshape(bsz, s_len, DA_HEADS, DA_V)
    lp = lam_params.astype(jnp.float32)
    lam = jnp.exp(jnp.sum(lp[0] * lp[1])) - jnp.exp(jnp.sum(lp[2] * lp[3])) + lam_init
    nb = s_len // Q_BLOCK
    key_chunk = jnp.arange(s_len) // CHUNK
    scale = DA_QK ** -0.5
    q_blocks = q.reshape(bsz, nb, Q_BLOCK, DA_HEADS, 2, DA_QK).swapaxes(0, 1)

    def one_block(args):
        qb, b_idx = args
        sc = jnp.einsum('bqhmd,bkhmd->bhmqk', qb, k).astype(jnp.float32) * scale
        q_chunk = (b_idx * Q_BLOCK + jnp.arange(Q_BLOCK)) // CHUNK
        mask = key_chunk[None, :] <= q_chunk[:, None]
        p = jax.nn.softmax(jnp.where(mask, sc, -jnp.inf), axis=-1)
        a = p[:, :, 0] - lam * p[:, :, 1]
        return jnp.einsum('bhqk,bkhd->bqhd', a.astype(v.dtype), v)

    o = lax.map(one_block, (q_blocks, jnp.arange(nb)))
    o = o.swapaxes(0, 1).reshape(bsz, s_len, DA_HEADS, DA_V)
    o = rms_norm(o, subln_w) * (1.0 - lam_init)
    return o.reshape(bsz, s_len, DA_HEADS * DA_V).astype(dq.dtype)


def segsum_exp(a_cs):
    l = a_cs.shape[-1]
    tril = jnp.tril(jnp.ones((l, l), dtype=bool))
    diff = a_cs[..., :, None] - a_cs[..., None, :]
    return jnp.where(tril, jnp.exp(jnp.where(tril, diff, 0.0)), 0.0)


def ssd_chunked(xh, dt, a_head, bm, cm):
    bsz, s_len, h, p = xh.shape
    n = bm.shape[-1]
    nc = s_len // CHUNK
    xdt = (xh.astype(jnp.float32) * dt[..., None]).reshape(bsz, nc, CHUNK, h, p)
    bc = bm.astype(jnp.float32).reshape(bsz, nc, CHUNK, h, n)
    cc = cm.astype(jnp.float32).reshape(bsz, nc, CHUNK, h, n)
    a = (dt * a_head).reshape(bsz, nc, CHUNK, h).transpose(0, 3, 1, 2)
    a_cs = jnp.cumsum(a, -1)
    lmat = segsum_exp(a_cs)
    cb = jnp.einsum('bclhn,bcshn->bhcls', cc, bc)
    y_diag = jnp.einsum('bhcls,bcshp->bclhp', cb * lmat, xdt)
    decay_states = jnp.exp(a_cs[..., -1:] - a_cs)
    states = jnp.einsum('bclhn,bhcl,bclhp->bchpn', bc, decay_states, xdt)
    chunk_decay = jnp.exp(a_cs[..., -1])

    def step(hst, inp):
        st, dec = inp
        return hst * dec[..., None, None] + st, hst

    h0 = jnp.zeros((bsz, h, p, n), jnp.float32)
    _, prev = lax.scan(step, h0, (states.swapaxes(0, 1), chunk_decay.transpose(2, 0, 1)))
    prev = prev.swapaxes(0, 1)
    y_off = jnp.einsum('bclhn,bchpn,bhcl->bclhp', cc, prev, jnp.exp(a_cs))
    return (y_diag + y_off).reshape(bsz, s_len, h, p)


def mamba2_mixer(mz, mxbc, mdt, conv_w, conv_b, dt_bias, a_log, d_skip, norm_w):
    bsz, s_len, _ = mz.shape
    xbc = jax.nn.silu(causal_dwconv(mxbc, conv_w) + conv_b)
    xs, bm, cm = jnp.split(xbc, [M_INNER, M_INNER + M_GROUPS * M_STATE], axis=-1)
    xh = xs.reshape(bsz, s_len, M_HEADS, M_HEADDIM)
    rep = M_HEADS // M_GROUPS
    bm = jnp.repeat(bm.reshape(bsz, s_len, M_GROUPS, M_STATE), rep, axis=2)
    cm = jnp.repeat(cm.reshape(bsz, s_len, M_GROUPS, M_STATE), rep, axis=2)
    dt = jax.nn.softplus(mdt.astype(jnp.float32) + dt_bias)
    a_head = -jnp.exp(a_log.astype(jnp.float32))
    y = ssd_chunked(xh, dt, a_head, bm, cm) + d_skip[:, None] * xh.astype(jnp.float32)
    y = y.reshape(bsz, s_len, M_INNER) * jax.nn.silu(mz.astype(jnp.float32))
    y = rms_norm(y.reshape(bsz, s_len, M_GROUPS, M_INNER // M_GROUPS), 1.0)
    y = y.reshape(bsz, s_len, M_INNER) * norm_w
    return y.astype(mz.dtype)


def chunk_gated_delta(q, k, v, g, beta):
    bsz, s_len, h, _ = q.shape
    dv = v.shape[-1]
    nc = s_len // CHUNK

    def to_chunks(t):
        return t.reshape(bsz, nc, CHUNK, h, -1).transpose(0, 3, 1, 2, 4)

    qc, kc, vc = to_chunks(q), to_chunks(k), to_chunks(v)
    bc = beta.reshape(bsz, nc, CHUNK, h).transpose(0, 3, 1, 2)
    gc = jnp.cumsum(g.reshape(bsz, nc, CHUNK, h).transpose(0, 3, 1, 2), -1)
    tril = jnp.tril(jnp.ones((CHUNK, CHUNK), dtype=bool))
    strict = jnp.tril(jnp.ones((CHUNK, CHUNK), dtype=bool), -1)
    decay = segsum_exp(gc)
    kb = kc * bc[..., None]
    vb = vc * bc[..., None]
    lmat = jnp.where(strict, jnp.einsum('bhcld,bhcsd->bhcls', kb, kc) * decay, 0.0)
    imat = jnp.eye(CHUNK, dtype=jnp.float32) + lmat
    u = lax.linalg.triangular_solve(imat, vb, left_side=True, lower=True, unit_diagonal=True)
    w = lax.linalg.triangular_solve(imat, kb * jnp.exp(gc)[..., None], left_side=True,
                                    lower=True, unit_diagonal=True)
    attn_intra = jnp.where(tril, jnp.einsum('bhcld,bhcsd->bhcls', qc, kc) * decay, 0.0)
    q_dec = qc * jnp.exp(gc)[..., None]
    k_dec = kc * jnp.exp(gc[..., -1:] - gc)[..., None]
    chunk_decay = jnp.exp(gc[..., -1])

    def step(st, inp):
        u_i, w_i, qd_i, kd_i, a_i, dec_i = inp
        v_new = u_i - jnp.einsum('bhld,bhdv->bhlv', w_i, st)
        o_i = jnp.einsum('bhld,bhdv->bhlv', qd_i, st) + jnp.einsum('bhls,bhsv->bhlv', a_i, v_new)
        st = st * dec_i[..., None, None] + jnp.einsum('bhld,bhlv->bhdv', kd_i, v_new)
        return st, o_i

    xs = tuple(jnp.moveaxis(t, 2, 0) for t in (u, w, q_dec, k_dec, attn_intra, chunk_decay))
    s0 = jnp.zeros((bsz, h, q.shape[-1], dv), jnp.float32)
    _, o = lax.scan(step, s0, xs)
    return o.transpose(1, 0, 3, 2, 4).reshape(bsz, s_len, h, dv)


def gated_deltanet_mixer(gq, gk, gv, gz, gb, ga, conv_w, a_log, dt_bias, norm_w):
    bsz, s_len, _ = gq.shape
    qkv = jax.nn.silu(causal_dwconv(jnp.concatenate([gq, gk, gv], -1), conv_w))
    q, k, v = jnp.split(qkv.astype(jnp.float32), [G_HEADS * G_DK, 2 * G_HEADS * G_DK], axis=-1)
    q = l2_normalize(q.reshape(bsz, s_len, G_HEADS, G_DK)) * (G_DK ** -0.5)
    k = l2_normalize(k.reshape(bsz, s_len, G_HEADS, G_DK))
    v = v.reshape(bsz, s_len, G_HEADS, G_DV)
    beta = jax.nn.sigmoid(gb.astype(jnp.float32))
    g = -jnp.exp(a_log.astype(jnp.float32)) * jax.nn.softplus(ga.astype(jnp.float32) + dt_bias)
    o = chunk_gated_delta(q, k, v, g, beta)
    o = rms_norm(o, norm_w) * jax.nn.silu(gz.astype(jnp.float32).reshape(bsz, s_len, G_HEADS, G_DV))
    return o.reshape(bsz, s_len, G_HEADS * G_DV).astype(gq.dtype)


def setup_inputs(seed: int = 0) -> dict:
    key = jax.random.key(seed)
    ks = iter(jax.random.split(key, 40))
    f32 = jnp.float32
    L = DEPTH

    def nrm(shape, scale):
        return jax.random.normal(next(ks), shape, f32) * scale

    def gain(shape):
        return 1.0 + nrm(shape, 0.02)

    def dt_bias_init(shape):
        u = jax.random.uniform(next(ks), shape, f32, minval=math.log(1e-3), maxval=math.log(1e-1))
        dt = jnp.exp(u)
        return dt + jnp.log(-jnp.expm1(-dt))

    def a_log_init(shape):
        return jnp.log(jax.random.uniform(next(ks), shape, f32, minval=1.0, maxval=16.0))

    return {
        'x': jax.random.normal(next(ks), (BATCH, SEQ, D_MODEL), f32),
        'ffn1_w_gu': nrm((L, D_MODEL, 2 * D_FF), D_MODEL ** -0.5),
        'ffn1_w_down': nrm((L, D_FF, D_MODEL), D_FF ** -0.5 * BETA_INIT),
        'ln1_g': gain((L, D_MODEL)),
        'ln1_b': nrm((L, D_MODEL), 0.02),
        'w_in': nrm((L, D_MODEL, D_IN), D_MODEL ** -0.5),
        'da_lambda': nrm((L, 4, DA_QK), 0.1),
        'da_subln_w': gain((L, DA_V)),
        'm_conv_w': nrm((L, CONV_K, M_INNER + 2 * M_GROUPS * M_STATE), CONV_K ** -0.5),
        'm_conv_b': nrm((L, M_INNER + 2 * M_GROUPS * M_STATE), 0.02),
        'm_dt_bias': dt_bias_init((L, M_HEADS)),
        'm_A_log': a_log_init((L, M_HEADS)),
        'm_D': gain((L, M_HEADS)),
        'm_norm_w': gain((L, M_INNER)),
        'g_conv_w': nrm((L, CONV_K, 2 * G_HEADS * G_DK + G_HEADS * G_DV), CONV_K ** -0.5),
        'g_A_log': a_log_init((L, G_HEADS)),
        'g_dt_bias': dt_bias_init((L, G_HEADS)),
        'g_norm_w': gain((L, G_DV)),
        'w_out': nrm((L, D_MIX, D_MODEL), D_MIX ** -0.5 * BETA_INIT),
        'ln2_g': gain((L, D_MODEL)),
        'ln2_b': nrm((L, D_MODEL), 0.02),
        'ffn2_w_gu': nrm((L, D_MODEL, 2 * D_FF), D_MODEL ** -0.5),
        'ffn2_w_down': nrm((L, D_FF, D_MODEL), D_FF ** -0.5 * BETA_INIT),
        'ln3_g': gain((L, D_MODEL)),
        'ln3_b': nrm((L, D_MODEL), 0.02),
    }


def reference(x, ffn1_w_gu, ffn1_w_down, ln1_g, ln1_b, w_in, da_lambda, da_subln_w,
              m_conv_w, m_conv_b, m_dt_bias, m_A_log, m_D, m_norm_w,
              g_conv_w, g_A_log, g_dt_bias, g_norm_w, w_out, ln2_g, ln2_b,
              ffn2_w_gu, ffn2_w_down, ln3_g, ln3_b):
    cos, sin = rope_tables(x.shape[1])
    for l in range(DEPTH):
        x = layer_norm(ALPHA * x + 0.5 * swiglu(x, ffn1_w_gu[l], ffn1_w_down[l]), ln1_g[l], ln1_b[l])
        h = x @ w_in[l]
        dq, dk, dv, mz, mxbc, mdt, gq, gk, gv, gz, gb, ga = jnp.split(h, IN_SPLITS, axis=-1)
        a_out = diff_attention_mixer(dq, dk, dv, cos, sin, da_lambda[l], da_subln_w[l], lambda_init(l))
        m_out = mamba2_mixer(mz, mxbc, mdt, m_conv_w[l], m_conv_b[l], m_dt_bias[l], m_A_log[l],
                             m_D[l], m_norm_w[l])
        g_out = gated_deltanet_mixer(gq, gk, gv, gz, gb, ga, g_conv_w[l], g_A_log[l], g_dt_bias[l],
                                     g_norm_w[l])
        mix = jnp.concatenate([a_out, m_out, g_out], -1).astype(x.dtype) @ w_out[l]
        x = layer_norm(ALPHA * x + mix, ln2_g[l], ln2_b[l])
        x = layer_norm(ALPHA * x + 0.5 * swiglu(x, ffn2_w_gu[l], ffn2_w_down[l]), ln3_g[l], ln3_b[l])
    return x
```

```cpp
#include <hip/hip_runtime.h>
#include <hip/hip_cooperative_groups.h>
#include <cstdio>
#include <cstdint>
namespace cg = cooperative_groups;
namespace pg8 {
#define PG8_LAS __attribute__((address_space(3)))
typedef unsigned short bf16_t;
typedef short bf16x8 __attribute__((ext_vector_type(8)));
typedef float f32x4 __attribute__((ext_vector_type(4)));
typedef unsigned u32x4 __attribute__((ext_vector_type(4)));
constexpr int BM = 256, BK = 64, HALF = 128, HTB = HALF * BK * 2  , STAGE_BYTES = 8 * HTB, NXCD = 8, WGM = 8;

__host__ __device__ __forceinline__ int lds_byte(int r, int c) { const int st = (r >> 4) * 2 + (c >> 5), rr = r & 15, cc = c & 31, ob = rr * 64 + cc * 2; return st * 1024 + (ob ^ (((ob >> 9) & 1) << 5)); }
__host__ __device__ __forceinline__ void stage_rc(int b, int& R, int& C) { const int st = b / 1024, sb = b % 1024, swz = sb ^ (((sb >> 9) & 1) << 5); R = (st >> 1) * 16 + swz / 64; C = (st & 1) * 32 + (swz % 64) / 2; }
__host__ __device__ __forceinline__ int perm32(int rho) { const int n = rho >> 4, i = rho & 15; return 8 * (i >> 2) + 4 * n + (i & 3); }

struct Unit { int pm, pn; };
struct Gemm { const bf16_t* A; const bf16_t* Bt; int M, N, K; };

struct StaticOrder {
    int nM, nN, nwg, G, c;
    __host__ __device__ void init(int M, int N, int G_, int c_) { nM = M / BM; nN = N / BM; nwg = nM * nN; G = G_; c = c_; }
    __host__ __device__ bool next(int i, Unit& u) const {
        const long L = (long)i * G + c; if (L >= nwg) return false;
        int wgid = (int)L; { const int q = nwg / NXCD, r = nwg % NXCD, xcd = wgid % NXCD, off = wgid / NXCD; wgid = (xcd < r ? xcd * (q + 1) : r * (q + 1) + (xcd - r) * q) + off; }
        const int nig = WGM * nN, gid = wgid / nig, fm = gid * WGM, gsz = (nM - fm) < WGM ? (nM - fm) : WGM;
        u.pm = fm + ((wgid % nig) % gsz); u.pn = (wgid % nig) / gsz; return true;
    }
    __device__ __forceinline__ void a_ready(const Unit&) const {}
    __device__ __forceinline__ void done(const Unit&) const {}
};

__device__ __forceinline__ unsigned cvt_pk_bf16(float lo, float hi) { unsigned r; asm volatile("v_cvt_pk_bf16_f32 %0, %1, %2" : "=v"(r) : "v"(lo), "v"(hi)); return r; }
typedef float f32x2 __attribute__((ext_vector_type(2)));
__device__ __forceinline__ f32x2 gelu_pk(f32x2 v) {
    const f32x2 av = __builtin_elementwise_abs(v), d = av * 0.2316418882f + 1.0f;
    f32x2 t; t.x = __builtin_amdgcn_rcpf(d.x); t.y = __builtin_amdgcn_rcpf(d.y);
    f32x2 q = t * 0.5307027145f + (-0.7265760135f); q = q * t + 0.7107068705f; q = q * t + (-0.142248368f); q = q * t + 0.127414796f; q = q * t;
    const f32x2 s = (v * v) * (-0.72134752044f);
    f32x2 e; e.x = __builtin_amdgcn_exp2f(s.x); e.y = __builtin_amdgcn_exp2f(s.y);
    const f32x2 m = v * (q * e), r = v - m;
    f32x2 o; o.x = v.x < 0.f ? m.x : r.x; o.y = v.y < 0.f ? m.y : r.y; return o;
}

template <int ACT  > struct EpiBf16 {
    static constexpr bool PERM = true, AFTER_DRAIN = false; static_assert(ACT == 0 || ACT == 1, "EpiBf16: ACT is 0 (none) or 1 (gelu_pk)");
    bf16_t* O; int ldc; const float* bias; int split_cols; size_t split_stride; float scale0;
    __device__ __forceinline__ void operator()(const f32x4 (&acc)[2][2][4][2], const Unit& u, int wr, int wc, int fr, int fq) const {
        const int row0 = u.pm * BM + wr * 64 + fr; int colt = u.pn * BM; bf16_t* base = O;
        float sc = 1.f; if (split_cols) { const int t = colt / split_cols; base += (size_t)t * split_stride; colt -= t * split_cols; if (t == 0) sc = scale0; }
        const int col0 = colt + wc * 32 + 8 * fq, bcol0 = u.pn * BM + wc * 32 + 8 * fq;
        f32x4 bv[2][2];
#pragma unroll
        for (int bj = 0; bj < 2; ++bj)
#pragma unroll
            for (int n = 0; n < 2; ++n) bv[bj][n] = bias ? *(const f32x4*)(bias + bcol0 + bj * HALF + 4 * n) : (f32x4){0.f, 0.f, 0.f, 0.f};
#pragma unroll
        for (int ai = 0; ai < 2; ++ai)
#pragma unroll
            for (int m = 0; m < 4; ++m) { bf16_t* rowp = base + (size_t)(row0 + ai * HALF + m * 16) * ldc + col0;
#pragma unroll
                for (int bj = 0; bj < 2; ++bj) { f32x4 v0 = acc[ai][bj][m][0] + bv[bj][0], v1 = acc[ai][bj][m][1] + bv[bj][1];
                    if (ACT == 1) { f32x2 a = gelu_pk((f32x2){v0[0], v0[1]}), b = gelu_pk((f32x2){v0[2], v0[3]}), c = gelu_pk((f32x2){v1[0], v1[1]}), d = gelu_pk((f32x2){v1[2], v1[3]});
                        v0 = (f32x4){a.x, a.y, b.x, b.y}; v1 = (f32x4){c.x, c.y, d.x, d.y}; }
                    v0 = v0 * sc; v1 = v1 * sc; u32x4 w; w.x = cvt_pk_bf16(v0[0], v0[1]); w.y = cvt_pk_bf16(v0[2], v0[3]); w.z = cvt_pk_bf16(v1[0], v1[1]); w.w = cvt_pk_bf16(v1[2], v1[3]);
                    *(u32x4*)(rowp + bj * HALF) = w; } }
    }
};

struct PanelStats {
    unsigned* xbuf;
    unsigned* cnt;
    unsigned* tmo;
    int ntn; float eps;
    unsigned code;
    __device__ __forceinline__ bool run(const f32x4 (&v)[2][2][4][2], const Unit& u, int wr, int wc, int fr, int fq, PG8_LAS unsigned char* lds, int wid, int lane) const {
        typedef float f32x2v __attribute__((ext_vector_type(2)));
        PG8_LAS f32x2v* P = (PG8_LAS f32x2v*)lds;
        PG8_LAS f32x2v* S = (PG8_LAS f32x2v*)(lds + 8192);
        PG8_LAS unsigned* flag = (PG8_LAS unsigned*)(lds + 8192 + 2048);
#pragma unroll
        for (int ai = 0; ai < 2; ++ai)
#pragma unroll
            for (int m = 0; m < 4; ++m) {
                float s = 0.f;
#pragma unroll
                for (int bj = 0; bj < 2; ++bj)
#pragma unroll
                    for (int n = 0; n < 2; ++n) { const f32x4 x = v[ai][bj][m][n]; s += (x[0] + x[1]) + (x[2] + x[3]); }
                s += __shfl_xor(s, 16); s += __shfl_xor(s, 32);
                const float mw = s * (1.0f / 64.0f); float q = 0.f;
#pragma unroll
                for (int bj = 0; bj < 2; ++bj)
#pragma unroll
                    for (int n = 0; n < 2; ++n) { const f32x4 d = v[ai][bj][m][n] - mw; q += (d[0] * d[0] + d[1] * d[1]) + (d[2] * d[2] + d[3] * d[3]); }
                q += __shfl_xor(q, 16); q += __shfl_xor(q, 32);
                if (fq == 0) P[(ai * HALF + wr * 64 + m * 16 + fr) * 4 + wc] = (f32x2v){mw, q};
            }
        asm volatile("s_waitcnt lgkmcnt(0)" ::: "memory"); __builtin_amdgcn_s_barrier(); asm volatile("" ::: "memory");
#if defined(BROKEN_EXCHANGE_NO_WAIT)
#warning BROKEN CONTROL BUILD: the row-statistics exchange does not wait; results are wrong by design
        if (blockIdx.x >= 64) { const long long t0_ = clock64(); while (clock64() - t0_ < 60000) __builtin_amdgcn_s_sleep(8); }
#endif
        const int row = wid * 32 + (lane & 31);
        if (lane < 32) {
            const f32x2v a = P[row * 4 + 0], b = P[row * 4 + 1], c = P[row * 4 + 2], d = P[row * 4 + 3];
            const float mt = (a.x + b.x + c.x + d.x) * 0.25f;
            const float da = a.x - mt, db = b.x - mt, dc = c.x - mt, dd = d.x - mt;
            const float m2 = (a.y + b.y) + (c.y + d.y) + 64.0f * ((da * da + db * db) + (dc * dc + dd * dd));
            unsigned long long* slot = (unsigned long long*)xbuf + ((size_t)(u.pm * BM + row) * 4 + u.pn);
            __hip_atomic_store(slot, ((unsigned long long)__float_as_uint(m2) << 32) | __float_as_uint(mt), __ATOMIC_RELAXED, __HIP_MEMORY_SCOPE_AGENT);
        }
        asm volatile("s_waitcnt vmcnt(0)" ::: "memory");
        if (lane == 0) __hip_atomic_fetch_add(cnt + 64 * u.pm, 1u, __ATOMIC_RELAXED, __HIP_MEMORY_SCOPE_AGENT);
        if (wid == 0) {
            bool dead = false; const unsigned long long t0 = __builtin_amdgcn_s_memrealtime(); const unsigned want = 8u * (unsigned)ntn;
            for (;;) {
#if defined(BROKEN_EXCHANGE_NO_WAIT)
                break;
#endif
                if ((unsigned)__builtin_amdgcn_readfirstlane(__hip_atomic_load(cnt + 64 * u.pm, __ATOMIC_RELAXED, __HIP_MEMORY_SCOPE_AGENT)) >= want) break;
                if (__builtin_amdgcn_s_memrealtime() - t0 > 2000000ull) {
                    if (lane == 0) { unsigned expect = 0u; __hip_atomic_compare_exchange_strong(tmo + 1, &expect, code | (unsigned)(u.pm & 0xff), __ATOMIC_RELAXED, __ATOMIC_RELAXED, __HIP_MEMORY_SCOPE_AGENT);
                                     __hip_atomic_store(tmo, 1u, __ATOMIC_RELAXED, __HIP_MEMORY_SCOPE_AGENT); }
                    dead = true; break; }
                __builtin_amdgcn_s_sleep(2);
            }
            __builtin_amdgcn_fence(__ATOMIC_ACQUIRE, "agent");
            if (lane == 0) flag[0] = dead ? 1u : 0u;
        }
        asm volatile("s_waitcnt vmcnt(0) lgkmcnt(0)" ::: "memory"); __builtin_amdgcn_s_barrier(); asm volatile("" ::: "memory");
        const bool bad = flag[0] != 0u;
        if (lane < 32) {
            const unsigned long long* slot = (const unsigned long long*)xbuf + (size_t)(u.pm * BM + row) * 4; float mt[4], m2[4]; float ms = 0.f;
#pragma unroll
            for (int t = 0; t < 4; ++t) { if (t < ntn) { const unsigned long long w = __hip_atomic_load(slot + t, __ATOMIC_RELAXED, __HIP_MEMORY_SCOPE_AGENT); mt[t] = __uint_as_float((unsigned)w); m2[t] = __uint_as_float((unsigned)(w >> 32)); } else { mt[t] = 0.f; m2[t] = 0.f; } ms += mt[t]; }
            const float mean = ms / (float)ntn; float q = 0.f;
#pragma unroll
            for (int t = 0; t < 4; ++t) if (t < ntn) { const float dm = mt[t] - mean; q += m2[t] + 256.0f * dm * dm; }
            S[row] = (f32x2v){mean, 1.0f / sqrtf(q / (256.0f * (float)ntn) + eps)};
        }
        asm volatile("s_waitcnt lgkmcnt(0)" ::: "memory"); __builtin_amdgcn_s_barrier(); asm volatile("" ::: "memory");
        return bad;
    }
};
struct EpiLnRes {
    static constexpr bool PERM = false, AFTER_DRAIN = true;
    const float* base; float* out; int ldc; const float* bias; PanelStats st; unsigned poison;
    __device__ __forceinline__ void fused(f32x4 (&acc)[2][2][4][2], const Unit& u, int wr, int wc, int fr, int fq, PG8_LAS unsigned char* lds, int wid, int lane) const {
        typedef float f32x2v __attribute__((ext_vector_type(2)));
        const PG8_LAS f32x2v* S = (const PG8_LAS f32x2v*)(lds + 8192);
        const int col0 = u.pn * BM + wc * 32 + 4 * fq;
#pragma unroll
        for (int bj = 0; bj < 2; ++bj)
#pragma unroll
            for (int n = 0; n < 2; ++n) { const f32x4 bv = bias ? *(const f32x4*)(bias + col0 + bj * HALF + n * 16) : (f32x4){0.f, 0.f, 0.f, 0.f};
#pragma unroll
                for (int ai = 0; ai < 2; ++ai)
#pragma unroll
                    for (int m = 0; m < 4; ++m) acc[ai][bj][m][n] += bv; }
        f32x4 pre[4][2][2];
#pragma unroll
        for (int m = 0; m < 4; ++m) { const size_t off = (size_t)(u.pm * BM + wr * 64 + m * 16 + fr) * ldc + col0;
#pragma unroll
            for (int bj = 0; bj < 2; ++bj)
#pragma unroll
                for (int n = 0; n < 2; ++n) pre[m][bj][n] = *(const f32x4*)(base + off + bj * HALF + n * 16); }
        const bool bad = st.run(acc, u, wr, wc, fr, fq, lds, wid, lane) || poison != 0u;
        const float qnan = __builtin_nanf("");
#pragma unroll
        for (int ai = 0; ai < 2; ++ai)
#pragma unroll
            for (int m = 0; m < 4; ++m) { const int r = ai * HALF + wr * 64 + m * 16 + fr; const f32x2v sr = S[r]; const size_t off = (size_t)(u.pm * BM + r) * ldc + col0;
#pragma unroll
                for (int bj = 0; bj < 2; ++bj)
#pragma unroll
                    for (int n = 0; n < 2; ++n) { const f32x4 bs = ai == 0 ? pre[m][bj][n] : *(const f32x4*)(base + off + bj * HALF + n * 16); f32x4 o = bs + (acc[ai][bj][m][n] - sr.x) * sr.y;
                        if (bad) o = (f32x4){qnan, qnan, qnan, qnan}; *(f32x4*)(out + off + bj * HALF + n * 16) = o; }
                if (m & 1) asm volatile("" ::: "memory"); }
    }
};
struct EpiLnResLn {
    static constexpr bool PERM = false, AFTER_DRAIN = true;
    const float* base; float* out; bf16_t* xn; int ldc; const float* bias; PanelStats st1, st2; unsigned poison;
    __device__ __forceinline__ void fused(f32x4 (&acc)[2][2][4][2], const Unit& u, int wr, int wc, int fr, int fq, PG8_LAS unsigned char* lds, int wid, int lane) const {
        typedef float f32x2v __attribute__((ext_vector_type(2))); typedef unsigned u32x2v __attribute__((ext_vector_type(2)));
        const PG8_LAS f32x2v* S = (const PG8_LAS f32x2v*)(lds + 8192);
        const int col0 = u.pn * BM + wc * 32 + 4 * fq;
#pragma unroll
        for (int bj = 0; bj < 2; ++bj)
#pragma unroll
            for (int n = 0; n < 2; ++n) { const f32x4 bv = bias ? *(const f32x4*)(bias + col0 + bj * HALF + n * 16) : (f32x4){0.f, 0.f, 0.f, 0.f};
#pragma unroll
                for (int ai = 0; ai < 2; ++ai)
#pragma unroll
                    for (int m = 0; m < 4; ++m) acc[ai][bj][m][n] += bv; }
        bool bad = st1.run(acc, u, wr, wc, fr, fq, lds, wid, lane) || poison != 0u;
        const float qnan = __builtin_nanf("");
#pragma unroll
        for (int ai = 0; ai < 2; ++ai)
#pragma unroll
            for (int m = 0; m < 4; ++m) { const int r = ai * HALF + wr * 64 + m * 16 + fr; const f32x2v sr = S[r]; const size_t off = (size_t)(u.pm * BM + r) * ldc + col0;
#pragma unroll
                for (int bj = 0; bj < 2; ++bj)
#pragma unroll
                    for (int n = 0; n < 2; ++n) { const f32x4 bs = *(const f32x4*)(base + off + bj * HALF + n * 16); acc[ai][bj][m][n] = bs + (acc[ai][bj][m][n] - sr.x) * sr.y; }
                asm volatile("" : "+v"(acc[ai][0][m][0]), "+v"(acc[ai][0][m][1]), "+v"(acc[ai][1][m][0]), "+v"(acc[ai][1][m][1]));
                if (m & 1) asm volatile("" ::: "memory"); }
        const bool bad1 = bad;
        bad = st2.run(acc, u, wr, wc, fr, fq, lds, wid, lane) || bad;
#pragma unroll
        for (int ai = 0; ai < 2; ++ai)
#pragma unroll
            for (int m = 0; m < 4; ++m) { const int r = ai * HALF + wr * 64 + m * 16 + fr; const f32x2v sr = S[r]; const size_t off = (size_t)(u.pm * BM + r) * ldc + col0;
#pragma unroll
                for (int bj = 0; bj < 2; ++bj)
#pragma unroll
                    for (int n = 0; n < 2; ++n) { const f32x4 x1 = acc[ai][bj][m][n]; *(f32x4*)(out + off + bj * HALF + n * 16) = bad1 ? (f32x4){qnan, qnan, qnan, qnan} : x1;
                        const f32x4 o = (x1 - sr.x) * sr.y; u32x2v w; w.x = cvt_pk_bf16(o[0], o[1]); w.y = cvt_pk_bf16(o[2], o[3]);
                        if (bad) { w.x = 0x7fc07fc0u; w.y = 0x7fc07fc0u; } *(u32x2v*)(xn + off + bj * HALF + n * 16) = w; }
                asm volatile("" ::: "memory"); }
    }
};

template <class Epi, class Sched, bool ALIGN_EPI = false, bool SP2 = false>
__device__ __forceinline__ void gemm_phase(PG8_LAS unsigned char* lds, const Gemm g, const Sched& S, const Epi& E) {
    int tid_l = threadIdx.x; asm volatile("" : "+v"(tid_l));
    const int tid = tid_l, wid = __builtin_amdgcn_readfirstlane(tid >> 6), lane = tid & 63, wr = wid >> 2, wc = wid & 3, fr = lane & 15, fq = lane >> 4;
    const int K = g.K, nt = K / BK;
    unsigned voffA[2], voffB[2];
#pragma unroll
    for (int i = 0; i < 2; ++i) { int R, C; stage_rc(tid * 16 + i * 8192, R, C); const int Rb = Epi::PERM ? ((R & ~31) + perm32(R & 31)) : R;
        voffA[i] = (unsigned)(R * K + C) * 2u; voffB[i] = (unsigned)(Rb * K + C) * 2u; }
    const size_t kstep = (size_t)(BK * 2);
    const size_t hstep = (size_t)HALF * K * 2;
    const size_t tstep = 2 * hstep;
    const unsigned ldsw = (unsigned)wid * 1024u;
    const int aoff = lds_byte(wr * 64 + fr, fq * 8), boff = lds_byte(wc * 32 + fr, fq * 8);
#define PG8_SA(b, h) (((b) * 2 + (h)) * HTB)
#define PG8_SB(b, h) ((4 + (b) * 2 + (h)) * HTB)
#define PG8_STAGE(bufoff, gbase, voff) do { _Pragma("unroll") for (int _i = 0; _i < 2; ++_i) \
        __builtin_amdgcn_global_load_lds((const unsigned*)((const char*)(gbase) + (voff)[_i]), (PG8_LAS unsigned*)(lds + (bufoff) + ldsw + _i * 8192), 16, 0, 0); } while (0)
#define PG8_LDA(dst, b, h) do { _Pragma("unroll") for (int m = 0; m < 4; ++m) _Pragma("unroll") for (int k = 0; k < 2; ++k) dst[m][k] = *(const PG8_LAS bf16x8*)(lds + PG8_SA(b, h) + aoff + m * 2048 + k * 1024); } while (0)
#define PG8_LDB(dst, b, h) do { _Pragma("unroll") for (int n = 0; n < 2; ++n) _Pragma("unroll") for (int k = 0; k < 2; ++k) dst[n][k] = *(const PG8_LAS bf16x8*)(lds + PG8_SB(b, h) + boff + n * 2048 + k * 1024); } while (0)
#define PG8_MMA(ai, bj, At, Bt) do { __builtin_amdgcn_s_setprio(1); _Pragma("unroll") for (int m = 0; m < 4; ++m) _Pragma("unroll") for (int n = 0; n < 2; ++n) _Pragma("unroll") for (int k = 0; k < 2; ++k) \
        acc[ai][bj][m][n] = __builtin_amdgcn_mfma_f32_16x16x32_bf16(Bt[n][k], At[m][k], acc[ai][bj][m][n], 0, 0, 0); __builtin_amdgcn_s_setprio(0); } while (0)
#define PG8_WAIT_V(n) asm volatile("s_waitcnt vmcnt(" #n ")" ::: "memory")
#define PG8_WAIT_L(n) asm volatile("s_waitcnt lgkmcnt(" #n ")" ::: "memory")
#define PG8_BAR __builtin_amdgcn_s_barrier()
#define PG8_SCHED __builtin_amdgcn_sched_barrier(0)
    Unit cur, nxt; int ui = 0;
    if (!S.next(0, cur)) return;
    f32x4 acc[2][2][4][2];
#pragma unroll
    for (int a = 0; a < 2; ++a)
#pragma unroll
        for (int b = 0; b < 2; ++b)
#pragma unroll
            for (int m = 0; m < 4; ++m)
#pragma unroll
                for (int n = 0; n < 2; ++n) acc[a][b][m][n] = (f32x4){0.f, 0.f, 0.f, 0.f};
    bf16x8 At[4][2], B0[2][2], B1[2][2];
    const char* cA = (const char*)g.A + (size_t)cur.pm * tstep; const char* cB = (const char*)g.Bt + (size_t)cur.pn * tstep;
    S.a_ready(cur);
    if constexpr (SP2) {
        PG8_STAGE(PG8_SB(0, 0), cB, voffB); PG8_STAGE(PG8_SB(0, 1), cB + hstep, voffB); PG8_STAGE(PG8_SA(0, 0), cA, voffA); PG8_STAGE(PG8_SA(0, 1), cA + hstep, voffA);
        if (wr == 1) PG8_BAR;
        PG8_WAIT_V(2); PG8_BAR;
        PG8_STAGE(PG8_SB(1, 0), cB + kstep, voffB); PG8_STAGE(PG8_SA(1, 0), cA + kstep, voffA); PG8_STAGE(PG8_SB(1, 1), cB + hstep + kstep, voffB);
        PG8_WAIT_V(6); PG8_BAR;
    } else {
        PG8_STAGE(PG8_SB(0, 0), cB, voffB); PG8_STAGE(PG8_SA(0, 0), cA, voffA); PG8_STAGE(PG8_SB(0, 1), cB + hstep, voffB); PG8_STAGE(PG8_SA(0, 1), cA + hstep, voffA);
        if (wr == 1) PG8_BAR;
        PG8_WAIT_V(4); PG8_BAR;
        PG8_STAGE(PG8_SB(1, 0), cB + kstep, voffB); PG8_STAGE(PG8_SA(1, 0), cA + kstep, voffA); PG8_STAGE(PG8_SB(1, 1), cB + hstep + kstep, voffB);
        PG8_WAIT_V(6); PG8_BAR;
    }
    for (;;) {
        const bool has_next = S.next(ui + 1, nxt);
        const char* nA = has_next ? (const char*)g.A + (size_t)nxt.pm * tstep : cA; const char* nB = has_next ? (const char*)g.Bt + (size_t)nxt.pn * tstep : cB;
        for (int t = 0; t < nt; t += 2) {
            const bool last = (t == nt - 2);
            const char* a1 = cA + (size_t)(t + 1) * kstep;
            const char* a2 = last ? nA : cA + (size_t)(t + 2) * kstep; const char* b2 = last ? nB : cB + (size_t)(t + 2) * kstep;
            const char* a3 = a2 + kstep; const char* b3 = b2 + kstep;
            if (last && has_next) S.a_ready(nxt);
            if constexpr (SP2) {
            PG8_LDB(B0, 0, 0); PG8_LDB(B1, 0, 1); PG8_SCHED; PG8_LDA(At, 0, 0); PG8_STAGE(PG8_SA(1, 1), a1 + hstep, voffA);
            PG8_WAIT_V(8); PG8_WAIT_L(0); PG8_BAR; PG8_MMA(0, 0, At, B0); PG8_MMA(0, 1, At, B1); PG8_BAR; PG8_SCHED;
            PG8_LDA(At, 0, 1); PG8_STAGE(PG8_SB(0, 0), b2, voffB); PG8_STAGE(PG8_SB(0, 1), b2 + hstep, voffB); PG8_STAGE(PG8_SA(0, 0), a2, voffA);
            PG8_WAIT_V(8); PG8_WAIT_L(0); PG8_BAR; PG8_MMA(1, 0, At, B0); PG8_MMA(1, 1, At, B1); PG8_BAR; PG8_SCHED;
            PG8_LDB(B0, 1, 0); PG8_LDB(B1, 1, 1); PG8_SCHED; PG8_LDA(At, 1, 0); PG8_STAGE(PG8_SA(0, 1), a2 + hstep, voffA);
            PG8_WAIT_V(8); PG8_WAIT_L(0); PG8_BAR; PG8_MMA(0, 0, At, B0); PG8_MMA(0, 1, At, B1); PG8_BAR; PG8_SCHED;
            PG8_LDA(At, 1, 1); PG8_STAGE(PG8_SB(1, 0), b3, voffB); PG8_STAGE(PG8_SB(1, 1), b3 + hstep, voffB); PG8_STAGE(PG8_SA(1, 0), a3, voffA);
            PG8_WAIT_V(8); PG8_WAIT_L(0); PG8_BAR; PG8_MMA(1, 0, At, B0); PG8_MMA(1, 1, At, B1); PG8_BAR; PG8_SCHED;
            } else {
            PG8_LDB(B0, 0, 0); PG8_SCHED; PG8_LDA(At, 0, 0); PG8_STAGE(PG8_SA(1, 1), a1 + hstep, voffA);
            PG8_WAIT_L(8); PG8_BAR; PG8_WAIT_L(0); PG8_MMA(0, 0, At, B0); PG8_BAR; PG8_SCHED;
            PG8_LDB(B1, 0, 1); PG8_STAGE(PG8_SB(0, 0), b2, voffB);
            PG8_BAR; PG8_WAIT_L(0); PG8_MMA(0, 1, At, B1); PG8_BAR;
            PG8_LDA(At, 0, 1); PG8_STAGE(PG8_SA(0, 0), a2, voffA);
            PG8_BAR; PG8_WAIT_L(0); PG8_MMA(1, 0, At, B0); PG8_BAR; PG8_SCHED;
            PG8_STAGE(PG8_SB(0, 1), b2 + hstep, voffB);
            PG8_WAIT_V(6); PG8_BAR; PG8_MMA(1, 1, At, B1); PG8_BAR;
            PG8_LDB(B0, 1, 0); PG8_SCHED; PG8_LDA(At, 1, 0); PG8_STAGE(PG8_SA(0, 1), a2 + hstep, voffA);
            PG8_WAIT_L(8); PG8_BAR; PG8_WAIT_L(0); PG8_MMA(0, 0, At, B0); PG8_BAR; PG8_SCHED;
            PG8_LDB(B1, 1, 1); PG8_STAGE(PG8_SB(1, 0), b3, voffB);
            PG8_BAR; PG8_WAIT_L(0); PG8_MMA(0, 1, At, B1); PG8_BAR;
            PG8_LDA(At, 1, 1); PG8_STAGE(PG8_SA(1, 0), a3, voffA);
            PG8_BAR; PG8_WAIT_L(0); PG8_MMA(1, 0, At, B0); PG8_BAR; PG8_SCHED;
            PG8_STAGE(PG8_SB(1, 1), b3 + hstep, voffB);
            PG8_WAIT_V(6); PG8_BAR; PG8_MMA(1, 1, At, B1); PG8_BAR;
            }
        }
        if constexpr (ALIGN_EPI) { if (wr == 0) PG8_BAR; }
        if constexpr (!Epi::AFTER_DRAIN) { E(acc, cur, wr, wc, fr, fq); S.done(cur); }
        if (!has_next) break;
#pragma unroll
        for (int a = 0; a < 2; ++a)
#pragma unroll
            for (int b = 0; b < 2; ++b)
#pragma unroll
                for (int m = 0; m < 4; ++m)
#pragma unroll
                    for (int n = 0; n < 2; ++n) acc[a][b][m][n] = (f32x4){0.f, 0.f, 0.f, 0.f};
        cur = nxt; cA = nA; cB = nB; ++ui;
        if constexpr (ALIGN_EPI) { if (wr == 1) PG8_BAR; }
    }
    PG8_WAIT_V(0);
    if constexpr (!ALIGN_EPI) { if (wr == 0) PG8_BAR; }
    PG8_BAR;
    if constexpr (Epi::AFTER_DRAIN) { E.fused(acc, cur, wr, wc, fr, fq, lds, wid, lane); S.done(cur); }
#undef PG8_SA
#undef PG8_SB
#undef PG8_STAGE
#undef PG8_LDA
#undef PG8_LDB
#undef PG8_MMA
#undef PG8_WAIT_V
#undef PG8_WAIT_L
#undef PG8_BAR
#undef PG8_SCHED
}
}
typedef unsigned short bf16_t;
#define LAS __attribute__((address_space(3)))
typedef float f32x4 __attribute__((ext_vector_type(4)));
typedef float f32x2 __attribute__((ext_vector_type(2)));
typedef float f32x16 __attribute__((ext_vector_type(16)));
typedef short bf16x8 __attribute__((ext_vector_type(8)));
typedef unsigned u32x4 __attribute__((ext_vector_type(4)));
typedef unsigned u32x2 __attribute__((ext_vector_type(2)));

constexpr int M = 16384, SEQ = 4096, D = 1024, DFF = 2816, NGU = 5632, DIN = 3344, DINP = 3584, DEPTH = 4;
constexpr float ALPHA = 1.681792830507429f;
constexpr float LN_EPS = 1e-5f;
constexpr int C_DQ = 0, C_DK = 256, C_DV = 512, C_MZ = 768, C_MXBC = 1280, C_MDT = 2304, C_GQ = 2312, C_GZ = 3080, C_GB = 3336, C_GA = 3340;

constexpr size_t MiB = 1u << 20;
constexpr size_t WS_ROPE = 1 * MiB;
constexpr size_t WS_WGU1 = 2 * MiB, WS_WD1 = 13 * MiB, WS_WGU2 = 19 * MiB, WS_WD2 = 30 * MiB, WS_WIN = 36 * MiB, WS_WOUT = 43 * MiB;
constexpr size_t WS_XN = 46 * MiB;
constexpr size_t WS_HB = 78 * MiB;
constexpr size_t WS_XC = 190 * MiB;
constexpr size_t WS_GQ = 222 * MiB;
constexpr size_t WS_SC = 246 * MiB;
constexpr size_t WS_YM = 248 * MiB;
constexpr size_t WS_OD = 280 * MiB;
constexpr size_t WS_MIX = 296 * MiB;
constexpr size_t WS_END = 328 * MiB;

constexpr int LDS_BYTES = 147456;
constexpr int NWAVES = 8;

__device__ __forceinline__ float bf2f(unsigned u) { return __uint_as_float(u << 16); }
__device__ __forceinline__ unsigned f2bf(float f) { unsigned u = __float_as_uint(f); return (u + 0x7fffu + ((u >> 16) & 1u)) >> 16; }
__device__ __forceinline__ unsigned pk2(float lo, float hi) { return f2bf(lo) | (f2bf(hi) << 16); }
__device__ __forceinline__ float silu_f(float x) { return x / (1.f + __expf(-x)); }
__device__ __forceinline__ float softplus_f(float x) { return fmaxf(x, 0.f) + log1pf(__expf(-fabsf(x))); }
__device__ __forceinline__ float sigmoid_f(float x) { return 1.f / (1.f + __expf(-x)); }

template <int CTRL> __device__ __forceinline__ float dpp_mov(float v) {
    return __builtin_bit_cast(float, __builtin_amdgcn_update_dpp(0, __builtin_bit_cast(int, v), CTRL, 0xF, 0xF, true));
}
__device__ __forceinline__ float wave_sum(float v) {
    v += dpp_mov<0xB1>(v);
    v += dpp_mov<0x4E>(v);
    v += dpp_mov<0x141>(v);
    v += dpp_mov<0x140>(v);
    { auto rr = __builtin_amdgcn_permlane16_swap(__float_as_uint(v), __float_as_uint(v), false, false); v = __uint_as_float(rr[0]) + __uint_as_float(rr[1]); }
    { auto rr = __builtin_amdgcn_permlane32_swap(__float_as_uint(v), __float_as_uint(v), false, false); v = __uint_as_float(rr[0]) + __uint_as_float(rr[1]); }
    return v;
}
__device__ __forceinline__ float xor32(float v) { auto rr = __builtin_amdgcn_permlane32_swap(__float_as_uint(v), __float_as_uint(v), false, false); return (threadIdx.x & 32) ? __uint_as_float(rr[0]) : __uint_as_float(rr[1]); }

namespace pg8 {
struct EpiSwiglu {
    static constexpr bool PERM = true, AFTER_DRAIN = false;
    bf16_t* O;
    __device__ __forceinline__ void operator()(const f32x4 (&acc)[2][2][4][2], const Unit& u, int wr, int wc, int fr, int fq) const {
        const int row0 = u.pm * BM + wr * 64 + fr; const int hid0 = u.pn * 128 + wc * 16 + 4 * fq;
#pragma unroll
        for (int ai = 0; ai < 2; ++ai)
#pragma unroll
            for (int m = 0; m < 4; ++m) { bf16_t* rowp = O + (size_t)(row0 + ai * HALF + m * 16) * 2816 + hid0;
#pragma unroll
                for (int bj = 0; bj < 2; ++bj) { const f32x4 g = acc[ai][bj][m][0], up = acc[ai][bj][m][1]; float v[4];
#pragma unroll
                    for (int j = 0; j < 4; ++j) v[j] = g[j] / (1.f + __expf(-g[j])) * up[j];
                    typedef unsigned u32x2v __attribute__((ext_vector_type(2))); u32x2v w; w.x = cvt_pk_bf16(v[0], v[1]); w.y = cvt_pk_bf16(v[2], v[3]);
                    *(u32x2v*)(rowp + bj * 64) = w; } }
    }
};
struct EpiResid {
    static constexpr bool PERM = false, AFTER_DRAIN = false;
    float* X; float alpha, s;
    __device__ __forceinline__ void operator()(const f32x4 (&acc)[2][2][4][2], const Unit& u, int wr, int wc, int fr, int fq) const {
        const int col0 = u.pn * BM + wc * 32 + 4 * fq;
#pragma unroll
        for (int ai = 0; ai < 2; ++ai)
#pragma unroll
            for (int m = 0; m < 4; ++m) { float* rowp = X + (size_t)(u.pm * BM + ai * HALF + wr * 64 + m * 16 + fr) * 1024 + col0;
#pragma unroll
                for (int bj = 0; bj < 2; ++bj)
#pragma unroll
                    for (int n = 0; n < 2; ++n) { f32x4* p = (f32x4*)(rowp + bj * HALF + n * 16); const f32x4 x = *p; *p = x * alpha + acc[ai][bj][m][n] * s; }
                asm volatile("" ::: "memory"); }
    }
};
struct EpiInproj {
    static constexpr bool PERM = true, AFTER_DRAIN = false;
    bf16_t* O; const float* rope;
    __device__ __forceinline__ void operator()(const f32x4 (&acc)[2][2][4][2], const Unit& u, int wr, int wc, int fr, int fq) const {
        const int row0 = u.pm * BM + wr * 64 + fr; const int col0 = u.pn * BM + wc * 32 + 8 * fq;
        const bool rot = (u.pn < 2) && (fq == 0);
#pragma unroll
        for (int ai = 0; ai < 2; ++ai)
#pragma unroll
            for (int m = 0; m < 4; ++m) { const int row = row0 + ai * HALF + m * 16; bf16_t* rowp = O + (size_t)row * 3584 + col0;
                f32x4 cs0 = {1.f, 0.f, 1.f, 0.f}, cs1 = {1.f, 0.f, 1.f, 0.f};
                if (rot) { const f32x4* rp = (const f32x4*)(rope + (size_t)(row & 4095) * 8); cs0 = rp[0]; cs1 = rp[1]; }
#pragma unroll
                for (int bj = 0; bj < 2; ++bj) { f32x4 v0 = acc[ai][bj][m][0], v1 = acc[ai][bj][m][1];
                    if (rot) { const float c[4] = {cs0[0], cs0[2], cs1[0], cs1[2]}, s[4] = {cs0[1], cs0[3], cs1[1], cs1[3]}; f32x4 a, b;
#pragma unroll
                        for (int j = 0; j < 4; ++j) { a[j] = v0[j] * c[j] - v1[j] * s[j]; b[j] = v1[j] * c[j] + v0[j] * s[j]; }
                        v0 = a; v1 = b; }
                    u32x4 w; w.x = cvt_pk_bf16(v0[0], v0[1]); w.y = cvt_pk_bf16(v0[2], v0[3]); w.z = cvt_pk_bf16(v1[0], v1[1]); w.w = cvt_pk_bf16(v1[2], v1[3]);
                    *(u32x4*)(rowp + bj * HALF) = w; } }
    }
};
}
struct Args { const float* in[25]; float* out; unsigned char* ws; };

template <int MODE>
__device__ __forceinline__ void transpose_item(const float* W, int K, int N, bf16_t* WT, LAS float* scr, int item, int lane) {
    const int nblk = (N + 31) / 32, kb = item / nblk, nb = item % nblk, k0 = 64 * kb, n0 = 32 * nb;
    const int col = n0 + (lane & 31);
#pragma unroll 8
    for (int i = 0; i < 32; ++i) { const int kk = 2 * i + (lane >> 5); scr[kk * 33 + (lane & 31)] = (col < N) ? W[(size_t)(k0 + kk) * N + col] : 0.f; }
    asm volatile("s_waitcnt lgkmcnt(0)" ::: "memory");
    const int c = lane & 7;
#pragma unroll
    for (int j = 0; j < 4; ++j) { const int n = (lane >> 3) + 8 * j; const LAS float* s = scr + (8 * c) * 33 + n;
        u32x4 o; o.x = pk2(s[0 * 33], s[1 * 33]); o.y = pk2(s[2 * 33], s[3 * 33]); o.z = pk2(s[4 * 33], s[5 * 33]); o.w = pk2(s[6 * 33], s[7 * 33]);
        int src = n0 + n, dst = src;
        if (MODE == 1) { const int nf = src >= DFF ? 1 : 0; const int uu = src - nf * DFF; dst = (uu >> 2) * 8 + nf * 4 + (uu & 3); }
        *(u32x4*)(WT + (size_t)dst * K + k0 + 8 * c) = o; }
    asm volatile("s_waitcnt lgkmcnt(0)" ::: "memory");
}
__device__ __forceinline__ void convert_layer(const Args& a, int l, LAS unsigned char* lds) {
    int tid_l = threadIdx.x; asm volatile("" : "+v"(tid_l)); const int tid = tid_l, lane = tid & 63, wave = __builtin_amdgcn_readfirstlane(tid >> 6); const int gw = blockIdx.x * NWAVES + wave, NGW = gridDim.x * NWAVES; (void)gw; (void)NGW; (void)lane; (void)wave;
    LAS float* scr = (LAS float*)(lds + wave * 16384);
    unsigned char* ws = a.ws;
    constexpr int I_GU = (D / 64) * (NGU / 32), I_D = (DFF / 64) * (D / 32), I_IN = (D / 64) * ((DIN + 31) / 32), I_OUT = (D / 64) * (D / 32);
    constexpr int NIT = 2 * I_GU + 2 * I_D + I_IN + I_OUT;
    for (int it = gw; it < NIT; it += NGW) {
        int r = it;
        if (r < I_GU) { transpose_item<1>(a.in[1] + (size_t)l * D * NGU, D, NGU, (bf16_t*)(ws + WS_WGU1), scr, r, lane); continue; } r -= I_GU;
        if (r < I_GU) { transpose_item<1>(a.in[21] + (size_t)l * D * NGU, D, NGU, (bf16_t*)(ws + WS_WGU2), scr, r, lane); continue; } r -= I_GU;
        if (r < I_D) { transpose_item<0>(a.in[2] + (size_t)l * DFF * D, DFF, D, (bf16_t*)(ws + WS_WD1), scr, r, lane); continue; } r -= I_D;
        if (r < I_D) { transpose_item<0>(a.in[22] + (size_t)l * DFF * D, DFF, D, (bf16_t*)(ws + WS_WD2), scr, r, lane); continue; } r -= I_D;
        if (r < I_IN) { transpose_item<0>(a.in[5] + (size_t)l * D * DIN, D, DIN, (bf16_t*)(ws + WS_WIN), scr, r, lane); continue; } r -= I_IN;
        transpose_item<0>(a.in[18] + (size_t)l * D * D, D, D, (bf16_t*)(ws + WS_WOUT), scr, r, lane);
    }
}

__device__ __forceinline__ void ln_rows(float* X, const float* g, const float* b, bf16_t* XN) {
    int tid_l = threadIdx.x; asm volatile("" : "+v"(tid_l)); const int tid = tid_l, lane = tid & 63, wave = __builtin_amdgcn_readfirstlane(tid >> 6); const int gw = blockIdx.x * NWAVES + wave, NGW = gridDim.x * NWAVES; (void)gw; (void)NGW; (void)lane; (void)wave;
    f32x4 gv[4], bv[4];
#pragma unroll
    for (int j = 0; j < 4; ++j) { gv[j] = ((const f32x4*)g)[lane + 64 * j]; bv[j] = ((const f32x4*)b)[lane + 64 * j]; }
    for (int m = gw; m < M; m += NGW) {
        f32x4* xr = (f32x4*)(X + (size_t)m * D) + lane;
        f32x4 v[4]; float s = 0.f;
#pragma unroll
        for (int j = 0; j < 4; ++j) { v[j] = xr[64 * j]; s += (v[j].x + v[j].y) + (v[j].z + v[j].w); }
        const float mean = wave_sum(s) * (1.f / D); float s2 = 0.f;
#pragma unroll
        for (int j = 0; j < 4; ++j) { v[j] = v[j] - mean; s2 += (v[j].x * v[j].x + v[j].y * v[j].y) + (v[j].z * v[j].z + v[j].w * v[j].w); }
        const float rstd = rsqrtf(wave_sum(s2) * (1.f / D) + LN_EPS);
        u32x2* o8 = (u32x2*)(XN + (size_t)m * D) + lane;
#pragma unroll
        for (int j = 0; j < 4; ++j) { const f32x4 y = v[j] * rstd * gv[j] + bv[j]; xr[64 * j] = y; u32x2 w; w.x = pk2(y.x, y.y); w.y = pk2(y.z, y.w); o8[64 * j] = w; }
    }
}

__device__ __forceinline__ void prologue(const Args& a) {
    int tid_l = threadIdx.x; asm volatile("" : "+v"(tid_l)); const int tid = tid_l, lane = tid & 63, wave = __builtin_amdgcn_readfirstlane(tid >> 6); const int gw = blockIdx.x * NWAVES + wave, NGW = gridDim.x * NWAVES; (void)gw; (void)NGW; (void)lane; (void)wave;
    float* rope = (float*)(a.ws + WS_ROPE);
    const int gt = gw * 64 + lane;
    if (gt < 4096 * 4) {
        const int pos = gt >> 2, i = gt & 3;
        const float invf = (i == 0) ? 1.0f : (i == 1) ? 0.03760603070259094f : (i == 2) ? 0.0014142135623842478f : 5.3182957344688475e-05f;
        const float ang = (float)pos * invf;
        const double x = (double)ang; const double k = rint(x * 0.15915494309189535); const double r = x - k * 6.283185307179586;
        const double r2 = r * r; double sn = 1.0, cs = 1.0, ts = 1.0, tc = 1.0;
#pragma unroll
        for (int n = 1; n <= 12; ++n) { tc *= -r2 / (double)((2 * n - 1) * (2 * n)); ts *= -r2 / (double)((2 * n) * (2 * n + 1)); cs += tc; sn += ts; }
        sn *= r;
        rope[gt * 2] = (float)cs; rope[gt * 2 + 1] = (float)sn;
    }
    const float* x = a.in[0]; float* X = a.out; bf16_t* XN = (bf16_t*)(a.ws + WS_XN);
    for (int m = gw; m < M; m += NGW) {
        const f32x4* xr = (const f32x4*)(x + (size_t)m * D) + lane; f32x4* o = (f32x4*)(X + (size_t)m * D) + lane; u32x2* o8 = (u32x2*)(XN + (size_t)m * D) + lane;
#pragma unroll
        for (int j = 0; j < 4; ++j) { const f32x4 v = xr[64 * j]; o[64 * j] = v; u32x2 w; w.x = pk2(v.x, v.y); w.y = pk2(v.z, v.w); o8[64 * j] = w; }
    }
}

__device__ __forceinline__ void prep_phase(const Args& a, int l, LAS unsigned char* lds) {
    int tid_l = threadIdx.x; asm volatile("" : "+v"(tid_l)); const int tid = tid_l, lane = tid & 63, wave = __builtin_amdgcn_readfirstlane(tid >> 6); const int gw = blockIdx.x * NWAVES + wave, NGW = gridDim.x * NWAVES; (void)gw; (void)NGW; (void)lane; (void)wave;
    const bf16_t* Hb = (const bf16_t*)(a.ws + WS_HB); bf16_t* XC = (bf16_t*)(a.ws + WS_XC); bf16_t* GQ = (bf16_t*)(a.ws + WS_GQ); float* SC = (float*)(a.ws + WS_SC);
    const float* mcw = a.in[8] + (size_t)l * 4 * 1024; const float* mcb = a.in[9] + (size_t)l * 1024;
    const float* mdtb = a.in[10] + l * 8; const float* mAl = a.in[11] + l * 8;
    const float* gcw = a.in[14] + (size_t)l * 4 * 768; const float* gAl = a.in[15] + l * 4; const float* gdtb = a.in[16] + l * 4;
    LAS float* qk = (LAS float*)lds;
    for (int blk = blockIdx.x; blk < M / 64; blk += gridDim.x) {
        const int row0 = blk * 64; const bool has_halo = (row0 & (SEQ - 1)) != 0;
        {
            const int ch = 2 * tid; const int col = C_MXBC + ch;
            float w[4][2], bias[2];
#pragma unroll
            for (int k = 0; k < 4; ++k) { w[k][0] = mcw[k * 1024 + ch]; w[k][1] = mcw[k * 1024 + ch + 1]; }
            bias[0] = mcb[ch]; bias[1] = mcb[ch + 1];
            float xm[3][2];
#pragma unroll
            for (int k = 0; k < 3; ++k) { unsigned u = 0; if (has_halo) u = *(const unsigned*)(Hb + (size_t)(row0 - 3 + k) * DINP + col); xm[k][0] = bf2f(u & 0xffffu); xm[k][1] = bf2f(u >> 16); }
#pragma unroll 4
            for (int r = 0; r < 64; ++r) {
                const unsigned u = *(const unsigned*)(Hb + (size_t)(row0 + r) * DINP + col); const float x0 = bf2f(u & 0xffffu), x1 = bf2f(u >> 16);
                const float a0 = w[0][0] * xm[0][0] + w[1][0] * xm[1][0] + w[2][0] * xm[2][0] + w[3][0] * x0 + bias[0];
                const float a1 = w[0][1] * xm[0][1] + w[1][1] * xm[1][1] + w[2][1] * xm[2][1] + w[3][1] * x1 + bias[1];
                *(unsigned*)(XC + (size_t)(row0 + r) * 1024 + ch) = pk2(silu_f(a0), silu_f(a1));
                xm[0][0] = xm[1][0]; xm[1][0] = xm[2][0]; xm[2][0] = x0; xm[0][1] = xm[1][1]; xm[1][1] = xm[2][1]; xm[2][1] = x1;
            }
        }
        if (tid < 384) {
            const int ch = 2 * tid; const int col = C_GQ + ch;
            float w[4][2];
#pragma unroll
            for (int k = 0; k < 4; ++k) { w[k][0] = gcw[k * 768 + ch]; w[k][1] = gcw[k * 768 + ch + 1]; }
            float xm[3][2];
#pragma unroll
            for (int k = 0; k < 3; ++k) { unsigned u = 0; if (has_halo) u = *(const unsigned*)(Hb + (size_t)(row0 - 3 + k) * DINP + col); xm[k][0] = bf2f(u & 0xffffu); xm[k][1] = bf2f(u >> 16); }
#pragma unroll 4
            for (int r = 0; r < 64; ++r) {
                const unsigned u = *(const unsigned*)(Hb + (size_t)(row0 + r) * DINP + col); const float x0 = bf2f(u & 0xffffu), x1 = bf2f(u >> 16);
                const float a0 = silu_f(w[0][0] * xm[0][0] + w[1][0] * xm[1][0] + w[2][0] * xm[2][0] + w[3][0] * x0);
                const float a1 = silu_f(w[0][1] * xm[0][1] + w[1][1] * xm[1][1] + w[2][1] * xm[2][1] + w[3][1] * x1);
                if (ch < 512) { qk[r * 512 + ch] = a0; qk[r * 512 + ch + 1] = a1; }
                else *(unsigned*)(GQ + (size_t)(row0 + r) * 768 + ch) = pk2(a0, a1);
                xm[0][0] = xm[1][0]; xm[1][0] = xm[2][0]; xm[2][0] = x0; xm[0][1] = xm[1][1]; xm[1][1] = xm[2][1]; xm[2][1] = x1;
            }
        } else {
            for (int it = tid - 384; it < 64 * 16; it += 128) {
                const int r = it >> 4, j = it & 15; const size_t row = row0 + r; const bf16_t* hr = Hb + row * DINP; float* sc = SC + row * 32;
                if (j < 8) { const float dt = softplus_f(bf2f(hr[C_MDT + j]) + mdtb[j]); sc[j] = dt; sc[8 + j] = __expf(-dt * __expf(mAl[j])); }
                else if (j < 12) { const int hh = j - 8; sc[16 + hh] = sigmoid_f(bf2f(hr[C_GB + hh])); }
                else { const int hh = j - 12; const float g = -__expf(gAl[hh]) * softplus_f(bf2f(hr[C_GA + hh]) + gdtb[hh]); sc[20 + hh] = __expf(g); }
            }
        }
        __syncthreads();
        for (int it = wave * 64; it < wave * 64 + 64; ++it) {
            const int r = it >> 3, hd = it & 7; const float v = qk[r * 512 + hd * 64 + lane];
            const float ss = wave_sum(v * v); const float sc = rsqrtf(ss + 1e-6f) * (hd < 4 ? 0.125f : 1.0f);
            GQ[(size_t)(row0 + r) * 768 + hd * 64 + lane] = (bf16_t)f2bf(v * sc);
        }
        __syncthreads();
    }
}

__device__ __forceinline__ void mamba_task(const Args& a, int task, int lane) {
    const bf16_t* XC = (const bf16_t*)(a.ws + WS_XC); const float* SC = (const float*)(a.ws + WS_SC); float* YM = (float*)(a.ws + WS_YM);
    const int b = task >> 8, h = (task >> 5) & 7, pp = task & 31, g = h >> 2;
    const size_t rowb = (size_t)b * SEQ;
    const unsigned* Bp = (const unsigned*)(XC + rowb * 1024 + 512 + g * 128) + lane;
    const unsigned* Cp = (const unsigned*)(XC + rowb * 1024 + 768 + g * 128) + lane;
    const unsigned* Xp = (const unsigned*)(XC + rowb * 1024 + h * 64 + 2 * pp);
    const float* Sp = SC + rowb * 32 + h;
    float* Yp = YM + rowb * 512 + h * 64 + 2 * pp;
    constexpr int T = 8;
    unsigned Bn[T], Cn[T], Xn[T]; float dtn[T], dAn[T];
#pragma unroll
    for (int i = 0; i < T; ++i) { Bn[i] = Bp[(size_t)i * 512]; Cn[i] = Cp[(size_t)i * 512]; Xn[i] = Xp[(size_t)i * 512]; dtn[i] = Sp[(size_t)i * 32]; dAn[i] = Sp[(size_t)i * 32 + 8]; }
    float h00 = 0.f, h01 = 0.f, h10 = 0.f, h11 = 0.f;
    for (int t0 = 0; t0 < SEQ; t0 += T) {
        unsigned Bc[T], Cc[T], Xc[T]; float dtc[T], dAc[T];
#pragma unroll
        for (int i = 0; i < T; ++i) { Bc[i] = Bn[i]; Cc[i] = Cn[i]; Xc[i] = Xn[i]; dtc[i] = dtn[i]; dAc[i] = dAn[i]; }
        if (t0 + T < SEQ) {
#pragma unroll
            for (int i = 0; i < T; ++i) { const size_t t = t0 + T + i; Bn[i] = Bp[t * 512]; Cn[i] = Cp[t * 512]; Xn[i] = Xp[t * 512]; dtn[i] = Sp[t * 32]; dAn[i] = Sp[t * 32 + 8]; }
        }
#pragma unroll
        for (int i = 0; i < T; ++i) {
            const float B0 = bf2f(Bc[i] & 0xffffu), B1 = bf2f(Bc[i] >> 16), C0 = bf2f(Cc[i] & 0xffffu), C1 = bf2f(Cc[i] >> 16);
            const float x0 = bf2f(Xc[i] & 0xffffu) * dtc[i], x1 = bf2f(Xc[i] >> 16) * dtc[i]; const float dA = dAc[i];
            h00 = h00 * dA + x0 * B0; h01 = h01 * dA + x0 * B1; h10 = h10 * dA + x1 * B0; h11 = h11 * dA + x1 * B1;
            const float y0 = wave_sum(C0 * h00 + C1 * h01), y1 = wave_sum(C0 * h10 + C1 * h11);
            if (lane == 0) { f32x2 yy = {y0, y1}; *(f32x2*)(Yp + (size_t)(t0 + i) * 512) = yy; }
        }
    }
}
__device__ __forceinline__ void delta_task(const Args& a, int task, int lane) {
    const bf16_t* GQ = (const bf16_t*)(a.ws + WS_GQ); const float* SC = (const float*)(a.ws + WS_SC); float* OD = (float*)(a.ws + WS_OD);
    const int b = task >> 8, hh = (task >> 6) & 3, dv = task & 63;
    const size_t rowb = (size_t)b * SEQ;
    const bf16_t* Qp = GQ + rowb * 768 + hh * 64 + lane; const bf16_t* Kp = Qp + 256; const bf16_t* Vp = GQ + rowb * 768 + 512 + hh * 64 + dv;
    const float* Sp = SC + rowb * 32 + 16 + hh; float* Op = OD + rowb * 256 + hh * 64 + dv;
    constexpr int T = 8;
    unsigned short qn[T], kn[T], vn_[T]; float btn[T], dcn[T];
#pragma unroll
    for (int i = 0; i < T; ++i) { qn[i] = Qp[(size_t)i * 768]; kn[i] = Kp[(size_t)i * 768]; vn_[i] = Vp[(size_t)i * 768]; btn[i] = Sp[(size_t)i * 32]; dcn[i] = Sp[(size_t)i * 32 + 4]; }
    float S = 0.f;
    for (int t0 = 0; t0 < SEQ; t0 += T) {
        unsigned short qc[T], kc[T], vc[T]; float btc[T], dcc[T];
#pragma unroll
        for (int i = 0; i < T; ++i) { qc[i] = qn[i]; kc[i] = kn[i]; vc[i] = vn_[i]; btc[i] = btn[i]; dcc[i] = dcn[i]; }
        if (t0 + T < SEQ) {
#pragma unroll
            for (int i = 0; i < T; ++i) { const size_t t = t0 + T + i; qn[i] = Qp[t * 768]; kn[i] = Kp[t * 768]; vn_[i] = Vp[t * 768]; btn[i] = Sp[t * 32]; dcn[i] = Sp[t * 32 + 4]; }
        }
#pragma unroll
        for (int i = 0; i < T; ++i) {
            const float q = bf2f(qc[i]), k = bf2f(kc[i]), v = bf2f(vc[i]), beta = btc[i], dec = dcc[i];
            const float ks = wave_sum(S * k);
            const float vnew = beta * (v - dec * ks);
            S = S * dec + k * vnew;
            const float o = wave_sum(S * q);
            if (lane == 0) Op[(size_t)(t0 + i) * 256] = o;
        }
    }
}

constexpr int AT_K = 0, AT_V = 16384, AT_WS = 16384 + 17408, AT_OST = AT_WS + 1024, AT_END = AT_OST + 8 * 32 * 65 * 4;
static_assert(AT_END <= 131072, "attention LDS");
__device__ __forceinline__ void attn_unit(const Args& a, int l, int b, int h, int qb, float lam, float lam_init, LAS unsigned char* lds) {
    int tid_l = threadIdx.x; asm volatile("" : "+v"(tid_l)); const int tid = tid_l, lane = tid & 63, wid = __builtin_amdgcn_readfirstlane(tid >> 6), r32 = lane & 31, hi = lane >> 5, map = wid >> 2, wq = wid & 3;
    const bf16_t* Hb = (const bf16_t*)(a.ws + WS_HB); bf16_t* MIX = (bf16_t*)(a.ws + WS_MIX);
    const size_t rowb = (size_t)b * SEQ; const int q0 = qb * 128;
    bf16x8 qr[2];
    { const bf16_t* qp = Hb + (rowb + q0 + wq * 32 + r32) * DINP + C_DQ + h * 64 + map * 32 + hi * 8; qr[0] = *(const bf16x8*)qp; qr[1] = *(const bf16x8*)(qp + 16); }
    const int NT = 2 * qb + 2; const int my_last = 2 * qb + (wq >> 1);
    const int kmap = tid >> 8, kkv = (tid & 255) >> 2, kc = tid & 3;
    const bf16_t* ksrc = Hb + (rowb + kkv) * DINP + C_DK + h * 64 + kmap * 32 + kc * 8;
    const int kdst = AT_K + kmap * 4096 + ((((kc >> 1) * 2 + (kkv >> 5)) * 2 + (kc & 1)) * 512) + (kkv & 31) * 16;
    const bf16_t* vsrc = Hb + (rowb + lane) * DINP + C_DV + h * 64 + wid * 8;
    const int vdst = AT_V + ((wid * 8) * 68 + lane) * 2;
    u32x4 kreg = *(const u32x4*)ksrc, vreg = *(const u32x4*)vsrc;
#define AT_WRITE(buf) do { *(LAS u32x4*)(lds + (buf) * 8192 + kdst) = kreg; LAS unsigned short* vp_ = (LAS unsigned short*)(lds + (buf) * 8704 + vdst); \
        vp_[0 * 68] = (unsigned short)(vreg.x & 0xffffu); vp_[1 * 68] = (unsigned short)(vreg.x >> 16); vp_[2 * 68] = (unsigned short)(vreg.y & 0xffffu); vp_[3 * 68] = (unsigned short)(vreg.y >> 16); \
        vp_[4 * 68] = (unsigned short)(vreg.z & 0xffffu); vp_[5 * 68] = (unsigned short)(vreg.z >> 16); vp_[6 * 68] = (unsigned short)(vreg.w & 0xffffu); vp_[7 * 68] = (unsigned short)(vreg.w >> 16); } while (0)
    AT_WRITE(0);
    __syncthreads();
    float m_run = -INFINITY, l_run = 0.f; f32x16 o0 = {}, o1 = {};
    LAS float* wsf = (LAS float*)(lds + AT_WS) + wid * 32;
    const float c = 0.25503486164919736f;
    for (int t = 0; t < NT; ++t) {
        if (t + 1 < NT) { kreg = *(const u32x4*)(ksrc + (size_t)(t + 1) * 64 * DINP); vreg = *(const u32x4*)(vsrc + (size_t)(t + 1) * 64 * DINP); }
        if (t <= my_last) {
            const int buf = t & 1;
            const LAS unsigned char* Kb = lds + buf * 8192 + AT_K + map * 4096;
            f32x16 p0 = {}, p1 = {};
#pragma unroll
            for (int d0 = 0; d0 < 2; ++d0) {
                const bf16x8 a0 = *(const LAS bf16x8*)(Kb + ((d0 * 2 + 0) * 2 + hi) * 512 + r32 * 16);
                const bf16x8 a1 = *(const LAS bf16x8*)(Kb + ((d0 * 2 + 1) * 2 + hi) * 512 + r32 * 16);
                p0 = __builtin_amdgcn_mfma_f32_32x32x16_bf16(a0, qr[d0], p0, 0, 0, 0);
                p1 = __builtin_amdgcn_mfma_f32_32x32x16_bf16(a1, qr[d0], p1, 0, 0, 0);
            }
            float mx = p0[0];
#pragma unroll
            for (int r = 1; r < 16; ++r) mx = fmaxf(mx, p0[r]);
#pragma unroll
            for (int r = 0; r < 16; ++r) mx = fmaxf(mx, p1[r]);
            mx = fmaxf(mx, xor32(mx));
            const float m_new = fmaxf(m_run, mx * c);
            const float alpha = exp2f(m_run - m_new);
            m_run = m_new;
            float rs = 0.f;
#pragma unroll
            for (int r = 0; r < 16; ++r) { p0[r] = exp2f(p0[r] * c - m_new); rs += p0[r]; }
#pragma unroll
            for (int r = 0; r < 16; ++r) { p1[r] = exp2f(p1[r] * c - m_new); rs += p1[r]; }
            l_run = l_run * alpha + rs;
            if (__any(alpha != 1.0f)) {
                if (hi == 0) wsf[r32] = alpha;
                asm volatile("s_waitcnt lgkmcnt(0)" ::: "memory");
#pragma unroll
                for (int r = 0; r < 16; ++r) { const float f = wsf[(r & 3) + 8 * (r >> 2) + 4 * hi]; o0[r] *= f; o1[r] *= f; }
            }
            bf16x8 pa[4];
#pragma unroll
            for (int ks = 0; ks < 4; ++ks) { u32x4 w;
                if (ks < 2) { const int o = 8 * ks; w.x = pk2(p0[o], p0[o + 1]); w.y = pk2(p0[o + 2], p0[o + 3]); w.z = pk2(p0[o + 4], p0[o + 5]); w.w = pk2(p0[o + 6], p0[o + 7]); }
                else { const int o = 8 * (ks - 2); w.x = pk2(p1[o], p1[o + 1]); w.y = pk2(p1[o + 2], p1[o + 3]); w.z = pk2(p1[o + 4], p1[o + 5]); w.w = pk2(p1[o + 6], p1[o + 7]); }
                pa[ks] = __builtin_bit_cast(bf16x8, w); }
            const LAS unsigned char* Vb = lds + buf * 8704 + AT_V;
#pragma unroll
            for (int ks = 0; ks < 4; ++ks) { const int kvb = 16 * (ks & 1) + 32 * (ks >> 1) + 4 * hi;
                { const LAS unsigned char* vp = Vb + (r32 * 68 + kvb) * 2; const u32x2 lo = *(const LAS u32x2*)vp, hh2 = *(const LAS u32x2*)(vp + 16);
                  u32x4 w = {lo.x, lo.y, hh2.x, hh2.y}; o0 = __builtin_amdgcn_mfma_f32_32x32x16_bf16(pa[ks], __builtin_bit_cast(bf16x8, w), o0, 0, 0, 0); }
                { const LAS unsigned char* vp = Vb + ((32 + r32) * 68 + kvb) * 2; const u32x2 lo = *(const LAS u32x2*)vp, hh2 = *(const LAS u32x2*)(vp + 16);
                  u32x4 w = {lo.x, lo.y, hh2.x, hh2.y}; o1 = __builtin_amdgcn_mfma_f32_32x32x16_bf16(pa[ks], __builtin_bit_cast(bf16x8, w), o1, 0, 0, 0); }
            }
        }
        if (t + 1 < NT) AT_WRITE((t + 1) & 1);
        __syncthreads();
    }
#undef AT_WRITE
    { const float lt = l_run + xor32(l_run);
      if (hi == 0) wsf[r32] = 1.0f / lt;
      asm volatile("s_waitcnt lgkmcnt(0)" ::: "memory");
      LAS float* ost = (LAS float*)(lds + AT_OST) + wid * (32 * 65);
#pragma unroll
      for (int r = 0; r < 16; ++r) { const int q = (r & 3) + 8 * (r >> 2) + 4 * hi; const float f = wsf[q]; ost[q * 65 + r32] = o0[r] * f; ost[q * 65 + 32 + r32] = o1[r] * f; } }
    __syncthreads();
    if (wid < 4) {
        const int q = lane >> 1, dh = lane & 1;
        const LAS float* o1p = (const LAS float*)(lds + AT_OST) + wid * (32 * 65) + q * 65 + dh * 32; const LAS float* o2p = o1p + 4 * (32 * 65);
        const float* sw = a.in[7] + l * 64 + dh * 32;
        float v[32]; float ss = 0.f;
#pragma unroll
        for (int e = 0; e < 32; ++e) { v[e] = o1p[e] - lam * o2p[e]; ss += v[e] * v[e]; }
        ss += dpp_mov<0xB1>(ss);
        const float rinv = rsqrtf(ss * (1.f / 64.f) + LN_EPS) * (1.f - lam_init);
        bf16_t* op = MIX + (rowb + q0 + wid * 32 + q) * 1024 + h * 64 + dh * 32;
#pragma unroll
        for (int e8 = 0; e8 < 4; ++e8) { u32x4 w; const int e = e8 * 8;
            w.x = pk2(v[e] * rinv * sw[e], v[e + 1] * rinv * sw[e + 1]); w.y = pk2(v[e + 2] * rinv * sw[e + 2], v[e + 3] * rinv * sw[e + 3]);
            w.z = pk2(v[e + 4] * rinv * sw[e + 4], v[e + 5] * rinv * sw[e + 5]); w.w = pk2(v[e + 6] * rinv * sw[e + 6], v[e + 7] * rinv * sw[e + 7]);
            *(u32x4*)(op + e) = w; }
    }
    __syncthreads();
}

__device__ __forceinline__ void post_phase(const Args& a, int l) {
    int tid_l = threadIdx.x; asm volatile("" : "+v"(tid_l)); const int tid = tid_l, lane = tid & 63, wave = __builtin_amdgcn_readfirstlane(tid >> 6); const int gw = blockIdx.x * NWAVES + wave, NGW = gridDim.x * NWAVES; (void)gw; (void)NGW; (void)lane; (void)wave;
    const bf16_t* Hb = (const bf16_t*)(a.ws + WS_HB); const bf16_t* XC = (const bf16_t*)(a.ws + WS_XC); const float* YM = (const float*)(a.ws + WS_YM); const float* OD = (const float*)(a.ws + WS_OD);
    bf16_t* MIX = (bf16_t*)(a.ws + WS_MIX);
    const float Dh = a.in[12][l * 8 + (lane >> 3)];
    f32x4 nw0 = *(const f32x4*)(a.in[13] + l * 512 + 8 * lane), nw1 = *(const f32x4*)(a.in[13] + l * 512 + 8 * lane + 4);
    const f32x4 gw4 = *(const f32x4*)(a.in[17] + l * 64 + 4 * (lane & 15));
    for (int row = gw; row < M; row += NGW) {
        {   const f32x4 y0 = *(const f32x4*)(YM + (size_t)row * 512 + 8 * lane), y1 = *(const f32x4*)(YM + (size_t)row * 512 + 8 * lane + 4);
            const u32x4 xc = *(const u32x4*)(XC + (size_t)row * 1024 + 8 * lane); const u32x4 z = *(const u32x4*)(Hb + (size_t)row * DINP + C_MZ + 8 * lane);
            float y[8] = {y0[0], y0[1], y0[2], y0[3], y1[0], y1[1], y1[2], y1[3]}; const unsigned xw[4] = {xc.x, xc.y, xc.z, xc.w}, zw[4] = {z.x, z.y, z.z, z.w};
            float ss = 0.f;
#pragma unroll
            for (int j = 0; j < 4; ++j) { y[2 * j] = (y[2 * j] + Dh * bf2f(xw[j] & 0xffffu)) * silu_f(bf2f(zw[j] & 0xffffu)); y[2 * j + 1] = (y[2 * j + 1] + Dh * bf2f(xw[j] >> 16)) * silu_f(bf2f(zw[j] >> 16));
                ss += y[2 * j] * y[2 * j] + y[2 * j + 1] * y[2 * j + 1]; }
            ss += dpp_mov<0xB1>(ss); ss += dpp_mov<0x4E>(ss); ss += dpp_mov<0x141>(ss); ss += dpp_mov<0x140>(ss);
            { auto rr = __builtin_amdgcn_permlane16_swap(__float_as_uint(ss), __float_as_uint(ss), false, false); ss = __uint_as_float(rr[0]) + __uint_as_float(rr[1]); }
            const float r = rsqrtf(ss * (1.f / 256.f) + LN_EPS);
            u32x4 w; w.x = pk2(y[0] * r * nw0[0], y[1] * r * nw0[1]); w.y = pk2(y[2] * r * nw0[2], y[3] * r * nw0[3]); w.z = pk2(y[4] * r * nw1[0], y[5] * r * nw1[1]); w.w = pk2(y[6] * r * nw1[2], y[7] * r * nw1[3]);
            *(u32x4*)(MIX + (size_t)row * 1024 + 256 + 8 * lane) = w; }
        {   const f32x4 o = *(const f32x4*)(OD + (size_t)row * 256 + 4 * lane); const u32x2 gz = *(const u32x2*)(Hb + (size_t)row * DINP + C_GZ + 4 * lane);
            float ss = o[0] * o[0] + o[1] * o[1] + o[2] * o[2] + o[3] * o[3];
            ss += dpp_mov<0xB1>(ss); ss += dpp_mov<0x4E>(ss); ss += dpp_mov<0x141>(ss); ss += dpp_mov<0x140>(ss);
            const float r = rsqrtf(ss * (1.f / 64.f) + LN_EPS);
            u32x2 w; w.x = pk2(o[0] * r * gw4[0] * silu_f(bf2f(gz.x & 0xffffu)), o[1] * r * gw4[1] * silu_f(bf2f(gz.x >> 16)));
            w.y = pk2(o[2] * r * gw4[2] * silu_f(bf2f(gz.y & 0xffffu)), o[3] * r * gw4[3] * silu_f(bf2f(gz.y >> 16)));
            *(u32x2*)(MIX + (size_t)row * 1024 + 768 + 4 * lane) = w; }
    }
}
__global__ void __launch_bounds__(512, 2) fwd_megakernel(Args a) {
    extern __shared__ __attribute__((aligned(16))) unsigned char lds_raw[];
    LAS unsigned char* lds = (LAS unsigned char*)lds_raw;
    cg::grid_group grid = cg::this_grid();
    const int G = gridDim.x;
    unsigned char* ws = a.ws;
    float* X = a.out; bf16_t* XN = (bf16_t*)(ws + WS_XN); bf16_t* HB = (bf16_t*)(ws + WS_HB); bf16_t* MIX = (bf16_t*)(ws + WS_MIX);
    const float beta_half = 0.5f;

#ifndef NO_PRO
    prologue(a);
    convert_layer(a, 0, lds);
#endif
    grid.sync();

    for (int l = 0; l < DEPTH; ++l) {
        { pg8::Gemm g{XN, (const bf16_t*)(ws + WS_WGU1), M, NGU, D}; pg8::StaticOrder S; S.init(M, NGU, G, (int)blockIdx.x); pg8::EpiSwiglu E{HB};
          pg8::gemm_phase<pg8::EpiSwiglu, pg8::StaticOrder, true, true>(lds, g, S, E); }
        grid.sync();
        { pg8::Gemm g{HB, (const bf16_t*)(ws + WS_WD1), M, D, DFF}; pg8::StaticOrder S; S.init(M, D, G, (int)blockIdx.x); pg8::EpiResid E{X, ALPHA, beta_half};
          pg8::gemm_phase<pg8::EpiResid, pg8::StaticOrder, true, true>(lds, g, S, E); }
        grid.sync();
        ln_rows(X, a.in[3] + l * D, a.in[4] + l * D, XN);
        grid.sync();
        { pg8::Gemm g{XN, (const bf16_t*)(ws + WS_WIN), M, DINP, D}; pg8::StaticOrder S; S.init(M, DINP, G, (int)blockIdx.x); pg8::EpiInproj E{HB, (const float*)(ws + WS_ROPE)};
          pg8::gemm_phase<pg8::EpiInproj, pg8::StaticOrder, true, true>(lds, g, S, E); }
        grid.sync();
#ifndef NO_PREP
        prep_phase(a, l, lds);
#endif
        grid.sync();
        {
            int tid_l = threadIdx.x; asm volatile("" : "+v"(tid_l)); const int lane = tid_l & 63, wave = __builtin_amdgcn_readfirstlane(tid_l >> 6);
            for (int tb = blockIdx.x; tb < 256; tb += G) {
#ifndef NO_REC
                if (wave < 4) mamba_task(a, tb * 4 + wave, lane); else delta_task(a, tb * 4 + (wave - 4), lane);
#endif
            }
            __syncthreads();
            const float* lp = a.in[6] + l * 128; float d1 = 0.f, d2 = 0.f;
            for (int i = 0; i < 32; ++i) { d1 += lp[i] * lp[32 + i]; d2 += lp[64 + i] * lp[96 + i]; }
            const float lam_init = 0.8f - 0.6f * __expf(-0.3f * (float)l);
            const float lam = __expf(d1) - __expf(d2) + lam_init;
            for (int u = blockIdx.x; u < 512; u += G) {
                const int j = u >> 8, v = u & 255, bh = v >> 4, s = v & 15, qb = j == 0 ? s : 31 - s;
#ifndef NO_ATTN
                attn_unit(a, l, bh >> 2, bh & 3, qb, lam, lam_init, lds);
#endif
            }
        }
        grid.sync();
#ifndef NO_POST
        post_phase(a, l);
#endif
        grid.sync();
        { pg8::Gemm g{MIX, (const bf16_t*)(ws + WS_WOUT), M, D, D}; pg8::StaticOrder S; S.init(M, D, G, (int)blockIdx.x); pg8::EpiResid E{X, ALPHA, 1.0f};
          pg8::gemm_phase<pg8::EpiResid, pg8::StaticOrder, true, true>(lds, g, S, E); }
        grid.sync();
        ln_rows(X, a.in[19] + l * D, a.in[20] + l * D, XN);
        grid.sync();
        { pg8::Gemm g{XN, (const bf16_t*)(ws + WS_WGU2), M, NGU, D}; pg8::StaticOrder S; S.init(M, NGU, G, (int)blockIdx.x); pg8::EpiSwiglu E{HB};
          pg8::gemm_phase<pg8::EpiSwiglu, pg8::StaticOrder, true, true>(lds, g, S, E); }
        grid.sync();
        { pg8::Gemm g{HB, (const bf16_t*)(ws + WS_WD2), M, D, DFF}; pg8::StaticOrder S; S.init(M, D, G, (int)blockIdx.x); pg8::EpiResid E{X, ALPHA, beta_half};
          pg8::gemm_phase<pg8::EpiResid, pg8::StaticOrder, true, true>(lds, g, S, E); }
        grid.sync();
        ln_rows(X, a.in[23] + l * D, a.in[24] + l * D, XN);
#ifndef NO_PRO
        if (l + 1 < DEPTH) convert_layer(a, l + 1, lds);
#endif
        grid.sync();
    }
}

extern "C" void kernel_launch(void* const* d_in, const int* in_sizes, int n_in, void* d_out, int out_size, void* d_ws, size_t ws_size, hipStream_t stream) {
    static int grid = 0;
    if (grid == 0) {
        if (n_in != 25 || out_size != M * D || ws_size < WS_END) { fprintf(stderr, "kernel_launch: unexpected shapes (n_in %d out %d ws %zu)\n", n_in, out_size, ws_size); grid = -1; return; }
        int dev = 0, cus = 0, per_cu = 0;
        hipGetDevice(&dev); hipDeviceGetAttribute(&cus, hipDeviceAttributeMultiprocessorCount, dev);
        if (hipFuncSetAttribute((const void*)fwd_megakernel, hipFuncAttributeMaxDynamicSharedMemorySize, LDS_BYTES) != hipSuccess) { fprintf(stderr, "kernel_launch: hipFuncSetAttribute failed\n"); grid = -1; return; }
        if (hipOccupancyMaxActiveBlocksPerMultiprocessor(&per_cu, (const void*)fwd_megakernel, 512, LDS_BYTES) != hipSuccess || per_cu < 1) { fprintf(stderr, "kernel_launch: occupancy query says %d\n", per_cu); per_cu = 1; }
        (void)hipGetLastError();
        grid = cus * per_cu; if (grid > 256) grid = 256;
    }
    if (grid < 0) return;
    Args a{};
    for (int i = 0; i < 25; ++i) a.in[i] = (const float*)d_in[i];
    a.out = (float*)d_out; a.ws = (unsigned char*)d_ws;
    void* args[] = {&a};
    hipError_t e = hipLaunchCooperativeKernel((const void*)fwd_megakernel, dim3(grid), dim3(512), args, LDS_BYTES, stream);
    if (e != hipSuccess) fprintf(stderr, "cooperative launch failed: %s (grid %d)\n", hipGetErrorString(e), grid);
}
```

```cpp
#include <hip/hip_runtime.h>
#include <hip/hip_cooperative_groups.h>
#include <cstdio>
#include <cstdint>
namespace cg = cooperative_groups;
namespace pg8 {
#define PG8_LAS __attribute__((address_space(3)))
typedef unsigned short bf16_t;
typedef short bf16x8 __attribute__((ext_vector_type(8)));
typedef float f32x4 __attribute__((ext_vector_type(4)));
typedef unsigned u32x4 __attribute__((ext_vector_type(4)));
constexpr int BM = 256, BK = 64, HALF = 128, HTB = HALF * BK * 2  , STAGE_BYTES = 8 * HTB, NXCD = 8, WGM = 8;

__host__ __device__ __forceinline__ int lds_byte(int r, int c) { const int st = (r >> 4) * 2 + (c >> 5), rr = r & 15, cc = c & 31, ob = rr * 64 + cc * 2; return st * 1024 + (ob ^ (((ob >> 9) & 1) << 5)); }
__host__ __device__ __forceinline__ void stage_rc(int b, int& R, int& C) { const int st = b / 1024, sb = b % 1024, swz = sb ^ (((sb >> 9) & 1) << 5); R = (st >> 1) * 16 + swz / 64; C = (st & 1) * 32 + (swz % 64) / 2; }
__host__ __device__ __forceinline__ int perm32(int rho) { const int n = rho >> 4, i = rho & 15; return 8 * (i >> 2) + 4 * n + (i & 3); }

struct Unit { int pm, pn; };
struct Gemm { const bf16_t* A; const bf16_t* Bt; int M, N, K; };

struct StaticOrder {
    int nM, nN, nwg, G, c;
    __host__ __device__ void init(int M, int N, int G_, int c_) { nM = M / BM; nN = N / BM; nwg = nM * nN; G = G_; c = c_; }
    __host__ __device__ bool next(int i, Unit& u) const {
        const long L = (long)i * G + c; if (L >= nwg) return false;
        int wgid = (int)L; { const int q = nwg / NXCD, r = nwg % NXCD, xcd = wgid % NXCD, off = wgid / NXCD; wgid = (xcd < r ? xcd * (q + 1) : r * (q + 1) + (xcd - r) * q) + off; }
        const int nig = WGM * nN, gid = wgid / nig, fm = gid * WGM, gsz = (nM - fm) < WGM ? (nM - fm) : WGM;
        u.pm = fm + ((wgid % nig) % gsz); u.pn = (wgid % nig) / gsz; return true;
    }
    __device__ __forceinline__ void a_ready(const Unit&) const {}
    __device__ __forceinline__ void done(const Unit&) const {}
};

__device__ __forceinline__ unsigned cvt_pk_bf16(float lo, float hi) { unsigned r; asm volatile("v_cvt_pk_bf16_f32 %0, %1, %2" : "=v"(r) : "v"(lo), "v"(hi)); return r; }
typedef float f32x2 __attribute__((ext_vector_type(2)));
__device__ __forceinline__ f32x2 gelu_pk(f32x2 v) {
    const f32x2 av = __builtin_elementwise_abs(v), d = av * 0.2316418882f + 1.0f;
    f32x2 t; t.x = __builtin_amdgcn_rcpf(d.x); t.y = __builtin_amdgcn_rcpf(d.y);
    f32x2 q = t * 0.5307027145f + (-0.7265760135f); q = q * t + 0.7107068705f; q = q * t + (-0.142248368f); q = q * t + 0.127414796f; q = q * t;
    const f32x2 s = (v * v) * (-0.72134752044f);
    f32x2 e; e.x = __builtin_amdgcn_exp2f(s.x); e.y = __builtin_amdgcn_exp2f(s.y);
    const f32x2 m = v * (q * e), r = v - m;
    f32x2 o; o.x = v.x < 0.f ? m.x : r.x; o.y = v.y < 0.f ? m.y : r.y; return o;
}

template <int ACT  > struct EpiBf16 {
    static constexpr bool PERM = true, AFTER_DRAIN = false; static_assert(ACT == 0 || ACT == 1, "EpiBf16: ACT is 0 (none) or 1 (gelu_pk)");
    bf16_t* O; int ldc; const float* bias; int split_cols; size_t split_stride; float scale0;
    __device__ __forceinline__ void operator()(const f32x4 (&acc)[2][2][4][2], const Unit& u, int wr, int wc, int fr, int fq) const {
        const int row0 = u.pm * BM + wr * 64 + fr; int colt = u.pn * BM; bf16_t* base = O;
        float sc = 1.f; if (split_cols) { const int t = colt / split_cols; base += (size_t)t * split_stride; colt -= t * split_cols; if (t == 0) sc = scale0; }
        const int col0 = colt + wc * 32 + 8 * fq, bcol0 = u.pn * BM + wc * 32 + 8 * fq;
        f32x4 bv[2][2];
#pragma unroll
        for (int bj = 0; bj < 2; ++bj)
#pragma unroll
            for (int n = 0; n < 2; ++n) bv[bj][n] = bias ? *(const f32x4*)(bias + bcol0 + bj * HALF + 4 * n) : (f32x4){0.f, 0.f, 0.f, 0.f};
#pragma unroll
        for (int ai = 0; ai < 2; ++ai)
#pragma unroll
            for (int m = 0; m < 4; ++m) { bf16_t* rowp = base + (size_t)(row0 + ai * HALF + m * 16) * ldc + col0;
#pragma unroll
                for (int bj = 0; bj < 2; ++bj) { f32x4 v0 = acc[ai][bj][m][0] + bv[bj][0], v1 = acc[ai][bj][m][1] + bv[bj][1];
                    if (ACT == 1) { f32x2 a = gelu_pk((f32x2){v0[0], v0[1]}), b = gelu_pk((f32x2){v0[2], v0[3]}), c = gelu_pk((f32x2){v1[0], v1[1]}), d = gelu_pk((f32x2){v1[2], v1[3]});
                        v0 = (f32x4){a.x, a.y, b.x, b.y}; v1 = (f32x4){c.x, c.y, d.x, d.y}; }
                    v0 = v0 * sc; v1 = v1 * sc; u32x4 w; w.x = cvt_pk_bf16(v0[0], v0[1]); w.y = cvt_pk_bf16(v0[2], v0[3]); w.z = cvt_pk_bf16(v1[0], v1[1]); w.w = cvt_pk_bf16(v1[2], v1[3]);
                    *(u32x4*)(rowp + bj * HALF) = w; } }
    }
};

struct PanelStats {
    unsigned* xbuf;
    unsigned* cnt;
    unsigned* tmo;
    int ntn; float eps;
    unsigned code;
    __device__ __forceinline__ bool run(const f32x4 (&v)[2][2][4][2], const Unit& u, int wr, int wc, int fr, int fq, PG8_LAS unsigned char* lds, int wid, int lane) const {
        typedef float f32x2v __attribute__((ext_vector_type(2)));
        PG8_LAS f32x2v* P = (PG8_LAS f32x2v*)lds;
        PG8_LAS f32x2v* S = (PG8_LAS f32x2v*)(lds + 8192);
        PG8_LAS unsigned* flag = (PG8_LAS unsigned*)(lds + 8192 + 2048);
#pragma unroll
        for (int ai = 0; ai < 2; ++ai)
#pragma unroll
            for (int m = 0; m < 4; ++m) {
                float s = 0.f;
#pragma unroll
                for (int bj = 0; bj < 2; ++bj)
#pragma unroll
                    for (int n = 0; n < 2; ++n) { const f32x4 x = v[ai][bj][m][n]; s += (x[0] + x[1]) + (x[2] + x[3]); }
                s += __shfl_xor(s, 16); s += __shfl_xor(s, 32);
                const float mw = s * (1.0f / 64.0f); float q = 0.f;
#pragma unroll
                for (int bj = 0; bj < 2; ++bj)
#pragma unroll
                    for (int n = 0; n < 2; ++n) { const f32x4 d = v[ai][bj][m][n] - mw; q += (d[0] * d[0] + d[1] * d[1]) + (d[2] * d[2] + d[3] * d[3]); }
                q += __shfl_xor(q, 16); q += __shfl_xor(q, 32);
                if (fq == 0) P[(ai * HALF + wr * 64 + m * 16 + fr) * 4 + wc] = (f32x2v){mw, q};
            }
        asm volatile("s_waitcnt lgkmcnt(0)" ::: "memory"); __builtin_amdgcn_s_barrier(); asm volatile("" ::: "memory");
#if defined(BROKEN_EXCHANGE_NO_WAIT)
#warning BROKEN CONTROL BUILD: the row-statistics exchange does not wait; results are wrong by design
        if (blockIdx.x >= 64) { const long long t0_ = clock64(); while (clock64() - t0_ < 60000) __builtin_amdgcn_s_sleep(8); }
#endif
        const int row = wid * 32 + (lane & 31);
        if (lane < 32) {
            const f32x2v a = P[row * 4 + 0], b = P[row * 4 + 1], c = P[row * 4 + 2], d = P[row * 4 + 3];
            const float mt = (a.x + b.x + c.x + d.x) * 0.25f;
            const float da = a.x - mt, db = b.x - mt, dc = c.x - mt, dd = d.x - mt;
            const float m2 = (a.y + b.y) + (c.y + d.y) + 64.0f * ((da * da + db * db) + (dc * dc + dd * dd));
            unsigned long long* slot = (unsigned long long*)xbuf + ((size_t)(u.pm * BM + row) * 4 + u.pn);
            __hip_atomic_store(slot, ((unsigned long long)__float_as_uint(m2) << 32) | __float_as_uint(mt), __ATOMIC_RELAXED, __HIP_MEMORY_SCOPE_AGENT);
        }
        asm volatile("s_waitcnt vmcnt(0)" ::: "memory");
        if (lane == 0) __hip_atomic_fetch_add(cnt + 64 * u.pm, 1u, __ATOMIC_RELAXED, __HIP_MEMORY_SCOPE_AGENT);
        if (wid == 0) {
            bool dead = false; const unsigned long long t0 = __builtin_amdgcn_s_memrealtime(); const unsigned want = 8u * (unsigned)ntn;
            for (;;) {
#if defined(BROKEN_EXCHANGE_NO_WAIT)
                break;
#endif
                if ((unsigned)__builtin_amdgcn_readfirstlane(__hip_atomic_load(cnt + 64 * u.pm, __ATOMIC_RELAXED, __HIP_MEMORY_SCOPE_AGENT)) >= want) break;
                if (__builtin_amdgcn_s_memrealtime() - t0 > 2000000ull) {
                    if (lane == 0) { unsigned expect = 0u; __hip_atomic_compare_exchange_strong(tmo + 1, &expect, code | (unsigned)(u.pm & 0xff), __ATOMIC_RELAXED, __ATOMIC_RELAXED, __HIP_MEMORY_SCOPE_AGENT);
                                     __hip_atomic_store(tmo, 1u, __ATOMIC_RELAXED, __HIP_MEMORY_SCOPE_AGENT); }
                    dead = true; break; }
                __builtin_amdgcn_s_sleep(2);
            }
            __builtin_amdgcn_fence(__ATOMIC_ACQUIRE, "agent");
            if (lane == 0) flag[0] = dead ? 1u : 0u;
        }
        asm volatile("s_waitcnt vmcnt(0) lgkmcnt(0)" ::: "memory"); __builtin_amdgcn_s_barrier(); asm volatile("" ::: "memory");
        const bool bad = flag[0] != 0u;
        if (lane < 32) {
            const unsigned long long* slot = (const unsigned long long*)xbuf + (size_t)(u.pm * BM + row) * 4; float mt[4], m2[4]; float ms = 0.f;
#pragma unroll
            for (int t = 0; t < 4; ++t) { if (t < ntn) { const unsigned long long w = __hip_atomic_load(slot + t, __ATOMIC_RELAXED, __HIP_MEMORY_SCOPE_AGENT); mt[t] = __uint_as_float((unsigned)w); m2[t] = __uint_as_float((unsigned)(w >> 32)); } else { mt[t] = 0.f; m2[t] = 0.f; } ms += mt[t]; }
            const float mean = ms / (float)ntn; float q = 0.f;
#pragma unroll
            for (int t = 0; t < 4; ++t) if (t < ntn) { const float dm = mt[t] - mean; q += m2[t] + 256.0f * dm * dm; }
            S[row] = (f32x2v){mean, 1.0f / sqrtf(q / (256.0f * (float)ntn) + eps)};
        }
        asm volatile("s_waitcnt lgkmcnt(0)" ::: "memory"); __builtin_amdgcn_s_barrier(); asm volatile("" ::: "memory");
        return bad;
    }
};
struct EpiLnRes {
    static constexpr bool PERM = false, AFTER_DRAIN = true;
    const float* base; float* out; int ldc; const float* bias; PanelStats st; unsigned poison;
    __device__ __forceinline__ void fused(f32x4 (&acc)[2][2][4][2], const Unit& u, int wr, int wc, int fr, int fq, PG8_LAS unsigned char* lds, int wid, int lane) const {
        typedef float f32x2v __attribute__((ext_vector_type(2)));
        const PG8_LAS f32x2v* S = (const PG8_LAS f32x2v*)(lds + 8192);
        const int col0 = u.pn * BM + wc * 32 + 4 * fq;
#pragma unroll
        for (int bj = 0; bj < 2; ++bj)
#pragma unroll
            for (int n = 0; n < 2; ++n) { const f32x4 bv = bias ? *(const f32x4*)(bias + col0 + bj * HALF + n * 16) : (f32x4){0.f, 0.f, 0.f, 0.f};
#pragma unroll
                for (int ai = 0; ai < 2; ++ai)
#pragma unroll
                    for (int m = 0; m < 4; ++m) acc[ai][bj][m][n] += bv; }
        f32x4 pre[4][2][2];
#pragma unroll
        for (int m = 0; m < 4; ++m) { const size_t off = (size_t)(u.pm * BM + wr * 64 + m * 16 + fr) * ldc + col0;
#pragma unroll
            for (int bj = 0; bj < 2; ++bj)
#pragma unroll
                for (int n = 0; n < 2; ++n) pre[m][bj][n] = *(const f32x4*)(base + off + bj * HALF + n * 16); }
        const bool bad = st.run(acc, u, wr, wc, fr, fq, lds, wid, lane) || poison != 0u;
        const float qnan = __builtin_nanf("");
#pragma unroll
        for (int ai = 0; ai < 2; ++ai)
#pragma unroll
            for (int m = 0; m < 4; ++m) { const int r = ai * HALF + wr * 64 + m * 16 + fr; const f32x2v sr = S[r]; const size_t off = (size_t)(u.pm * BM + r) * ldc + col0;
#pragma unroll
                for (int bj = 0; bj < 2; ++bj)
#pragma unroll
                    for (int n = 0; n < 2; ++n) { const f32x4 bs = ai == 0 ? pre[m][bj][n] : *(const f32x4*)(base + off + bj * HALF + n * 16); f32x4 o = bs + (acc[ai][bj][m][n] - sr.x) * sr.y;
                        if (bad) o = (f32x4){qnan, qnan, qnan, qnan}; *(f32x4*)(out + off + bj * HALF + n * 16) = o; }
                if (m & 1) asm volatile("" ::: "memory"); }
    }
};
struct EpiLnResLn {
    static constexpr bool PERM = false, AFTER_DRAIN = true;
    const float* base; float* out; bf16_t* xn; int ldc; const float* bias; PanelStats st1, st2; unsigned poison;
    __device__ __forceinline__ void fused(f32x4 (&acc)[2][2][4][2], const Unit& u, int wr, int wc, int fr, int fq, PG8_LAS unsigned char* lds, int wid, int lane) const {
        typedef float f32x2v __attribute__((ext_vector_type(2))); typedef unsigned u32x2v __attribute__((ext_vector_type(2)));
        const PG8_LAS f32x2v* S = (const PG8_LAS f32x2v*)(lds + 8192);
        const int col0 = u.pn * BM + wc * 32 + 4 * fq;
#pragma unroll
        for (int bj = 0; bj < 2; ++bj)
#pragma unroll
            for (int n = 0; n < 2; ++n) { const f32x4 bv = bias ? *(const f32x4*)(bias + col0 + bj * HALF + n * 16) : (f32x4){0.f, 0.f, 0.f, 0.f};
#pragma unroll
                for (int ai = 0; ai < 2; ++ai)
#pragma unroll
                    for (int m = 0; m < 4; ++m) acc[ai][bj][m][n] += bv; }
        bool bad = st1.run(acc, u, wr, wc, fr, fq, lds, wid, lane) || poison != 0u;
        const float qnan = __builtin_nanf("");
#pragma unroll
        for (int ai = 0; ai < 2; ++ai)
#pragma unroll
            for (int m = 0; m < 4; ++m) { const int r = ai * HALF + wr * 64 + m * 16 + fr; const f32x2v sr = S[r]; const size_t off = (size_t)(u.pm * BM + r) * ldc + col0;
#pragma unroll
                for (int bj = 0; bj < 2; ++bj)
#pragma unroll
                    for (int n = 0; n < 2; ++n) { const f32x4 bs = *(const f32x4*)(base + off + bj * HALF + n * 16); acc[ai][bj][m][n] = bs + (acc[ai][bj][m][n] - sr.x) * sr.y; }
                asm volatile("" : "+v"(acc[ai][0][m][0]), "+v"(acc[ai][0][m][1]), "+v"(acc[ai][1][m][0]), "+v"(acc[ai][1][m][1]));
                if (m & 1) asm volatile("" ::: "memory"); }
        const bool bad1 = bad;
        bad = st2.run(acc, u, wr, wc, fr, fq, lds, wid, lane) || bad;
#pragma unroll
        for (int ai = 0; ai < 2; ++ai)
#pragma unroll
            for (int m = 0; m < 4; ++m) { const int r = ai * HALF + wr * 64 + m * 16 + fr; const f32x2v sr = S[r]; const size_t off = (size_t)(u.pm * BM + r) * ldc + col0;
#pragma unroll
                for (int bj = 0; bj < 2; ++bj)
#pragma unroll
                    for (int n = 0; n < 2; ++n) { const f32x4 x1 = acc[ai][bj][m][n]; *(f32x4*)(out + off + bj * HALF + n * 16) = bad1 ? (f32x4){qnan, qnan, qnan, qnan} : x1;
                        const f32x4 o = (x1 - sr.x) * sr.y; u32x2v w; w.x = cvt_pk_bf16(o[0], o[1]); w.y = cvt_pk_bf16(o[2], o[3]);
                        if (bad) { w.x = 0x7fc07fc0u; w.y = 0x7fc07fc0u; } *(u32x2v*)(xn + off + bj * HALF + n * 16) = w; }
                asm volatile("" ::: "memory"); }
    }
};

template <class Epi, class Sched, bool ALIGN_EPI = false, bool SP2 = false>
__device__ __forceinline__ void gemm_phase(PG8_LAS unsigned char* lds, const Gemm g, const Sched& S, const Epi& E) {
    int tid_l = threadIdx.x; asm volatile("" : "+v"(tid_l));
    const int tid = tid_l, wid = __builtin_amdgcn_readfirstlane(tid >> 6), lane = tid & 63, wr = wid >> 2, wc = wid & 3, fr = lane & 15, fq = lane >> 4;
    const int K = g.K, nt = K / BK;
    unsigned voffA[2], voffB[2];
#pragma unroll
    for (int i = 0; i < 2; ++i) { int R, C; stage_rc(tid * 16 + i * 8192, R, C); const int Rb = Epi::PERM ? ((R & ~31) + perm32(R & 31)) : R;
        voffA[i] = (unsigned)(R * K + C) * 2u; voffB[i] = (unsigned)(Rb * K + C) * 2u; }
    const size_t kstep = (size_t)(BK * 2);
    const size_t hstep = (size_t)HALF * K * 2;
    const size_t tstep = 2 * hstep;
    const unsigned ldsw = (unsigned)wid * 1024u;
    const int aoff = lds_byte(wr * 64 + fr, fq * 8), boff = lds_byte(wc * 32 + fr, fq * 8);
#define PG8_SA(b, h) (((b) * 2 + (h)) * HTB)
#define PG8_SB(b, h) ((4 + (b) * 2 + (h)) * HTB)
#define PG8_STAGE(bufoff, gbase, voff) do { _Pragma("unroll") for (int _i = 0; _i < 2; ++_i) \
        __builtin_amdgcn_global_load_lds((const unsigned*)((const char*)(gbase) + (voff)[_i]), (PG8_LAS unsigned*)(lds + (bufoff) + ldsw + _i * 8192), 16, 0, 0); } while (0)
#define PG8_LDA(dst, b, h) do { _Pragma("unroll") for (int m = 0; m < 4; ++m) _Pragma("unroll") for (int k = 0; k < 2; ++k) dst[m][k] = *(const PG8_LAS bf16x8*)(lds + PG8_SA(b, h) + aoff + m * 2048 + k * 1024); } while (0)
#define PG8_LDB(dst, b, h) do { _Pragma("unroll") for (int n = 0; n < 2; ++n) _Pragma("unroll") for (int k = 0; k < 2; ++k) dst[n][k] = *(const PG8_LAS bf16x8*)(lds + PG8_SB(b, h) + boff + n * 2048 + k * 1024); } while (0)
#define PG8_MMA(ai, bj, At, Bt) do { __builtin_amdgcn_s_setprio(1); _Pragma("unroll") for (int m = 0; m < 4; ++m) _Pragma("unroll") for (int n = 0; n < 2; ++n) _Pragma("unroll") for (int k = 0; k < 2; ++k) \
        acc[ai][bj][m][n] = __builtin_amdgcn_mfma_f32_16x16x32_bf16(Bt[n][k], At[m][k], acc[ai][bj][m][n], 0, 0, 0); __builtin_amdgcn_s_setprio(0); } while (0)
#define PG8_WAIT_V(n) asm volatile("s_waitcnt vmcnt(" #n ")" ::: "memory")
#define PG8_WAIT_L(n) asm volatile("s_waitcnt lgkmcnt(" #n ")" ::: "memory")
#define PG8_BAR __builtin_amdgcn_s_barrier()
#define PG8_SCHED __builtin_amdgcn_sched_barrier(0)
    Unit cur, nxt; int ui = 0;
    if (!S.next(0, cur)) return;
    f32x4 acc[2][2][4][2];
#pragma unroll
    for (int a = 0; a < 2; ++a)
#pragma unroll
        for (int b = 0; b < 2; ++b)
#pragma unroll
            for (int m = 0; m < 4; ++m)
#pragma unroll
                for (int n = 0; n < 2; ++n) acc[a][b][m][n] = (f32x4){0.f, 0.f, 0.f, 0.f};
    bf16x8 At[4][2], B0[2][2], B1[2][2];
    const char* cA = (const char*)g.A + (size_t)cur.pm * tstep; const char* cB = (const char*)g.Bt + (size_t)cur.pn * tstep;
    S.a_ready(cur);
    if constexpr (SP2) {
        PG8_STAGE(PG8_SB(0, 0), cB, voffB); PG8_STAGE(PG8_SB(0, 1), cB + hstep, voffB); PG8_STAGE(PG8_SA(0, 0), cA, voffA); PG8_STAGE(PG8_SA(0, 1), cA + hstep, voffA);
        if (wr == 1) PG8_BAR;
        PG8_WAIT_V(2); PG8_BAR;
        PG8_STAGE(PG8_SB(1, 0), cB + kstep, voffB); PG8_STAGE(PG8_SA(1, 0), cA + kstep, voffA); PG8_STAGE(PG8_SB(1, 1), cB + hstep + kstep, voffB);
        PG8_WAIT_V(6); PG8_BAR;
    } else {
        PG8_STAGE(PG8_SB(0, 0), cB, voffB); PG8_STAGE(PG8_SA(0, 0), cA, voffA); PG8_STAGE(PG8_SB(0, 1), cB + hstep, voffB); PG8_STAGE(PG8_SA(0, 1), cA + hstep, voffA);
        if (wr == 1) PG8_BAR;
        PG8_WAIT_V(4); PG8_BAR;
        PG8_STAGE(PG8_SB(1, 0), cB + kstep, voffB); PG8_STAGE(PG8_SA(1, 0), cA + kstep, voffA); PG8_STAGE(PG8_SB(1, 1), cB + hstep + kstep, voffB);
        PG8_WAIT_V(6); PG8_BAR;
    }
    for (;;) {
        const bool has_next = S.next(ui + 1, nxt);
        const char* nA = has_next ? (const char*)g.A + (size_t)nxt.pm * tstep : cA; const char* nB = has_next ? (const char*)g.Bt + (size_t)nxt.pn * tstep : cB;
        for (int t = 0; t < nt; t += 2) {
            const bool last = (t == nt - 2);
            const char* a1 = cA + (size_t)(t + 1) * kstep;
            const char* a2 = last ? nA : cA + (size_t)(t + 2) * kstep; const char* b2 = last ? nB : cB + (size_t)(t + 2) * kstep;
            const char* a3 = a2 + kstep; const char* b3 = b2 + kstep;
            if (last && has_next) S.a_ready(nxt);
            if constexpr (SP2) {
            PG8_LDB(B0, 0, 0); PG8_LDB(B1, 0, 1); PG8_SCHED; PG8_LDA(At, 0, 0); PG8_STAGE(PG8_SA(1, 1), a1 + hstep, voffA);
            PG8_WAIT_V(8); PG8_WAIT_L(0); PG8_BAR; PG8_MMA(0, 0, At, B0); PG8_MMA(0, 1, At, B1); PG8_BAR; PG8_SCHED;
            PG8_LDA(At, 0, 1); PG8_STAGE(PG8_SB(0, 0), b2, voffB); PG8_STAGE(PG8_SB(0, 1), b2 + hstep, voffB); PG8_STAGE(PG8_SA(0, 0), a2, voffA);
            PG8_WAIT_V(8); PG8_WAIT_L(0); PG8_BAR; PG8_MMA(1, 0, At, B0); PG8_MMA(1, 1, At, B1); PG8_BAR; PG8_SCHED;
            PG8_LDB(B0, 1, 0); PG8_LDB(B1, 1, 1); PG8_SCHED; PG8_LDA(At, 1, 0); PG8_STAGE(PG8_SA(0, 1), a2 + hstep, voffA);
            PG8_WAIT_V(8); PG8_WAIT_L(0); PG8_BAR; PG8_MMA(0, 0, At, B0); PG8_MMA(0, 1, At, B1); PG8_BAR; PG8_SCHED;
            PG8_LDA(At, 1, 1); PG8_STAGE(PG8_SB(1, 0), b3, voffB); PG8_STAGE(PG8_SB(1, 1), b3 + hstep, voffB); PG8_STAGE(PG8_SA(1, 0), a3, voffA);
            PG8_WAIT_V(8); PG8_WAIT_L(0); PG8_BAR; PG8_MMA(1, 0, At, B0); PG8_MMA(1, 1, At, B1); PG8_BAR; PG8_SCHED;
            } else {
            PG8_LDB(B0, 0, 0); PG8_SCHED; PG8_LDA(At, 0, 0); PG8_STAGE(PG8_SA(1, 1), a1 + hstep, voffA);
            PG8_WAIT_L(8); PG8_BAR; PG8_WAIT_L(0); PG8_MMA(0, 0, At, B0); PG8_BAR; PG8_SCHED;
            PG8_LDB(B1, 0, 1); PG8_STAGE(PG8_SB(0, 0), b2, voffB);
            PG8_BAR; PG8_WAIT_L(0); PG8_MMA(0, 1, At, B1); PG8_BAR;
            PG8_LDA(At, 0, 1); PG8_STAGE(PG8_SA(0, 0), a2, voffA);
            PG8_BAR; PG8_WAIT_L(0); PG8_MMA(1, 0, At, B0); PG8_BAR; PG8_SCHED;
            PG8_STAGE(PG8_SB(0, 1), b2 + hstep, voffB);
            PG8_WAIT_V(6); PG8_BAR; PG8_MMA(1, 1, At, B1); PG8_BAR;
            PG8_LDB(B0, 1, 0); PG8_SCHED; PG8_LDA(At, 1, 0); PG8_STAGE(PG8_SA(0, 1), a2 + hstep, voffA);
            PG8_WAIT_L(8); PG8_BAR; PG8_WAIT_L(0); PG8_MMA(0, 0, At, B0); PG8_BAR; PG8_SCHED;
            PG8_LDB(B1, 1, 1); PG8_STAGE(PG8_SB(1, 0), b3, voffB);
            PG8_BAR; PG8_WAIT_L(0); PG8_MMA(0, 1, At, B1); PG8_BAR;
            PG8_LDA(At, 1, 1); PG8_STAGE(PG8_SA(1, 0), a3, voffA);
            PG8_BAR; PG8_WAIT_L(0); PG8_MMA(1, 0, At, B0); PG8_BAR; PG8_SCHED;
            PG8_STAGE(PG8_SB(1, 1), b3 + hstep, voffB);
            PG8_WAIT_V(6); PG8_BAR; PG8_MMA(1, 1, At, B1); PG8_BAR;
            }
        }
        if constexpr (ALIGN_EPI) { if (wr == 0) PG8_BAR; }
        if constexpr (!Epi::AFTER_DRAIN) { E(acc, cur, wr, wc, fr, fq); S.done(cur); }
        if (!has_next) break;
#pragma unroll
        for (int a = 0; a < 2; ++a)
#pragma unroll
            for (int b = 0; b < 2; ++b)
#pragma unroll
                for (int m = 0; m < 4; ++m)
#pragma unroll
                    for (int n = 0; n < 2; ++n) acc[a][b][m][n] = (f32x4){0.f, 0.f, 0.f, 0.f};
        cur = nxt; cA = nA; cB = nB; ++ui;
        if constexpr (ALIGN_EPI) { if (wr == 1) PG8_BAR; }
    }
    PG8_WAIT_V(0);
    if constexpr (!ALIGN_EPI) { if (wr == 0) PG8_BAR; }
    PG8_BAR;
    if constexpr (Epi::AFTER_DRAIN) { E.fused(acc, cur, wr, wc, fr, fq, lds, wid, lane); S.done(cur); }
#undef PG8_SA
#undef PG8_SB
#undef PG8_STAGE
#undef PG8_LDA
#undef PG8_LDB
#undef PG8_MMA
#undef PG8_WAIT_V
#undef PG8_WAIT_L
#undef PG8_BAR
#undef PG8_SCHED
}
}
typedef unsigned short bf16_t;
#define LAS __attribute__((address_space(3)))
typedef float f32x4 __attribute__((ext_vector_type(4)));
typedef float f32x2 __attribute__((ext_vector_type(2)));
typedef float f32x16 __attribute__((ext_vector_type(16)));
typedef short bf16x8 __attribute__((ext_vector_type(8)));
typedef unsigned u32x4 __attribute__((ext_vector_type(4)));
typedef unsigned u32x2 __attribute__((ext_vector_type(2)));

constexpr int M = 16384, SEQ = 4096, D = 1024, DFF = 2816, NGU = 5632, DIN = 3344, DINP = 3584, DEPTH = 4;
constexpr float ALPHA = 1.681792830507429f;
constexpr float LN_EPS = 1e-5f;
constexpr int C_DQ = 0, C_DK = 256, C_DV = 512, C_MZ = 768, C_MXBC = 1280, C_MDT = 2304, C_GQ = 2312, C_GZ = 3080, C_GB = 3336, C_GA = 3340;

constexpr size_t MiB = 1u << 20;
constexpr size_t WS_ROPE = 1 * MiB;
constexpr size_t WS_WGU1 = 2 * MiB, WS_WD1 = 13 * MiB, WS_WGU2 = 19 * MiB, WS_WD2 = 30 * MiB, WS_WIN = 36 * MiB, WS_WOUT = 43 * MiB;
constexpr size_t WS_XN = 46 * MiB;
constexpr size_t WS_HB = 78 * MiB;
constexpr size_t WS_XC = 190 * MiB;
constexpr size_t WS_GQ = 222 * MiB;
constexpr size_t WS_SC = 246 * MiB;
constexpr size_t WS_YM = 248 * MiB;
constexpr size_t WS_OD = 280 * MiB;
constexpr size_t WS_MIX = 296 * MiB;
constexpr size_t WS_END = 328 * MiB;

constexpr int LDS_BYTES = 147456;
constexpr int NWAVES = 8;

__device__ __forceinline__ float bf2f(unsigned u) { return __uint_as_float(u << 16); }
__device__ __forceinline__ unsigned f2bf(float f) { unsigned u = __float_as_uint(f); return (u + 0x7fffu + ((u >> 16) & 1u)) >> 16; }
__device__ __forceinline__ unsigned pk2(float lo, float hi) { return f2bf(lo) | (f2bf(hi) << 16); }
__device__ __forceinline__ float silu_f(float x) { return x / (1.f + __expf(-x)); }
__device__ __forceinline__ float softplus_f(float x) { return fmaxf(x, 0.f) + log1pf(__expf(-fabsf(x))); }
__device__ __forceinline__ float sigmoid_f(float x) { return 1.f / (1.f + __expf(-x)); }

template <int CTRL> __device__ __forceinline__ float dpp_mov(float v) {
    return __builtin_bit_cast(float, __builtin_amdgcn_update_dpp(0, __builtin_bit_cast(int, v), CTRL, 0xF, 0xF, true));
}
__device__ __forceinline__ float wave_sum(float v) {
    v += dpp_mov<0xB1>(v);
    v += dpp_mov<0x4E>(v);
    v += dpp_mov<0x141>(v);
    v += dpp_mov<0x140>(v);
    { auto rr = __builtin_amdgcn_permlane16_swap(__float_as_uint(v), __float_as_uint(v), false, false); v = __uint_as_float(rr[0]) + __uint_as_float(rr[1]); }
    { auto rr = __builtin_amdgcn_permlane32_swap(__float_as_uint(v), __float_as_uint(v), false, false); v = __uint_as_float(rr[0]) + __uint_as_float(rr[1]); }
    return v;
}
__device__ __forceinline__ float xor32(float v) { auto rr = __builtin_amdgcn_permlane32_swap(__float_as_uint(v), __float_as_uint(v), false, false); return (threadIdx.x & 32) ? __uint_as_float(rr[0]) : __uint_as_float(rr[1]); }

namespace pg8 {
struct EpiSwiglu {
    static constexpr bool PERM = true, AFTER_DRAIN = false;
    bf16_t* O;
    __device__ __forceinline__ void operator()(const f32x4 (&acc)[2][2][4][2], const Unit& u, int wr, int wc, int fr, int fq) const {
        const int row0 = u.pm * BM + wr * 64 + fr; const int hid0 = u.pn * 128 + wc * 16 + 4 * fq;
#pragma unroll
        for (int ai = 0; ai < 2; ++ai)
#pragma unroll
            for (int m = 0; m < 4; ++m) { bf16_t* rowp = O + (size_t)(row0 + ai * HALF + m * 16) * 2816 + hid0;
#pragma unroll
                for (int bj = 0; bj < 2; ++bj) { const f32x4 g = acc[ai][bj][m][0], up = acc[ai][bj][m][1]; float v[4];
#pragma unroll
                    for (int j = 0; j < 4; ++j) v[j] = g[j] / (1.f + __expf(-g[j])) * up[j];
                    typedef unsigned u32x2v __attribute__((ext_vector_type(2))); u32x2v w; w.x = cvt_pk_bf16(v[0], v[1]); w.y = cvt_pk_bf16(v[2], v[3]);
                    *(u32x2v*)(rowp + bj * 64) = w; } }
    }
};
struct EpiResid {
    static constexpr bool PERM = false, AFTER_DRAIN = false;
    float* X; float alpha, s;
    __device__ __forceinline__ void operator()(const f32x4 (&acc)[2][2][4][2], const Unit& u, int wr, int wc, int fr, int fq) const {
        const int col0 = u.pn * BM + wc * 32 + 4 * fq;
#pragma unroll
        for (int ai = 0; ai < 2; ++ai)
#pragma unroll
            for (int m = 0; m < 4; ++m) { float* rowp = X + (size_t)(u.pm * BM + ai * HALF + wr * 64 + m * 16 + fr) * 1024 + col0;
#pragma unroll
                for (int bj = 0; bj < 2; ++bj)
#pragma unroll
                    for (int n = 0; n < 2; ++n) { f32x4* p = (f32x4*)(rowp + bj * HALF + n * 16); const f32x4 x = *p; *p = x * alpha + acc[ai][bj][m][n] * s; }
                asm volatile("" ::: "memory"); }
    }
};
struct EpiInproj {
    static constexpr bool PERM = true, AFTER_DRAIN = false;
    bf16_t* O; const float* rope;
    __device__ __forceinline__ void operator()(const f32x4 (&acc)[2][2][4][2], const Unit& u, int wr, int wc, int fr, int fq) const {
        const int row0 = u.pm * BM + wr * 64 + fr; const int col0 = u.pn * BM + wc * 32 + 8 * fq;
        const bool rot = (u.pn < 2) && (fq == 0);
#pragma unroll
        for (int ai = 0; ai < 2; ++ai)
#pragma unroll
            for (int m = 0; m < 4; ++m) { const int row = row0 + ai * HALF + m * 16; bf16_t* rowp = O + (size_t)row * 3584 + col0;
                f32x4 cs0 = {1.f, 0.f, 1.f, 0.f}, cs1 = {1.f, 0.f, 1.f, 0.f};
                if (rot) { const f32x4* rp = (const f32x4*)(rope + (size_t)(row & 4095) * 8); cs0 = rp[0]; cs1 = rp[1]; }
#pragma unroll
                for (int bj = 0; bj < 2; ++bj) { f32x4 v0 = acc[ai][bj][m][0], v1 = acc[ai][bj][m][1];
                    if (rot) { const float c[4] = {cs0[0], cs0[2], cs1[0], cs1[2]}, s[4] = {cs0[1], cs0[3], cs1[1], cs1[3]}; f32x4 a, b;
#pragma unroll
                        for (int j = 0; j < 4; ++j) { a[j] = v0[j] * c[j] - v1[j] * s[j]; b[j] = v1[j] * c[j] + v0[j] * s[j]; }
                        v0 = a; v1 = b; }
                    u32x4 w; w.x = cvt_pk_bf16(v0[0], v0[1]); w.y = cvt_pk_bf16(v0[2], v0[3]); w.z = cvt_pk_bf16(v1[0], v1[1]); w.w = cvt_pk_bf16(v1[2], v1[3]);
                    *(u32x4*)(rowp + bj * HALF) = w; } }
    }
};
}
#define XB_TMO      128
#define XB_XCNT(j)  (256  + 64 * (j))
#define XB_XSUB(j)  (1280 + 64 * (j))
#define XB_XGEN(j)  (2304 + 64 * (j))
#define XB_TOP      3328
#define XB_TOPGEN   3392
#define XCD_BAR_WORDS 3456
#define XB_SPIN_CAP (1u << 18)

__device__ __forceinline__ unsigned xb_ld(unsigned* p)              { return __hip_atomic_load(p, __ATOMIC_RELAXED, __HIP_MEMORY_SCOPE_AGENT); }
__device__ __forceinline__ unsigned xb_add(unsigned* p, unsigned v) { return __hip_atomic_fetch_add(p, v, __ATOMIC_RELAXED, __HIP_MEMORY_SCOPE_AGENT); }
__device__ __forceinline__ unsigned xb_xcc_id() { return (unsigned)__builtin_amdgcn_s_getreg((3 << 11) | 20) & 0xFu; }
#define XB_SPIN(cond, bar) do { unsigned _sp = 0; while (cond) { __builtin_amdgcn_s_sleep(1); \
    if ((++_sp & 255u) == 0u) { if (xb_ld(&(bar)[XB_TMO])) break; if (_sp > XB_SPIN_CAP) { atomicAdd(&(bar)[XB_TMO], 1u); break; } } } } while (0)

struct XcdBarrier {
    unsigned* bar; unsigned x;
    volatile LAS unsigned* st;
};

__device__ __forceinline__ XcdBarrier xcd_barrier_post(unsigned* bar, volatile LAS unsigned* st) {
    XcdBarrier b; b.bar = bar; b.x = xb_xcc_id(); b.st = st;
    if (threadIdx.x == 0) (void)xb_add(&bar[XB_XCNT(b.x)], 1u);
    return b;
}
__device__ __forceinline__ void xcd_barrier_complete(unsigned* bar, unsigned x, unsigned& nloc, unsigned& nx) {
    const unsigned G = gridDim.x * gridDim.y * gridDim.z;
    unsigned sum, cnt, mine, sp = 0u;
    for (;;) {
        sum = 0u; cnt = 0u; mine = 0u;
#pragma unroll
        for (unsigned j = 0; j < 16; ++j) { const unsigned c = xb_ld(&bar[XB_XCNT(j)]); sum += c; cnt += (c > 0u) ? 1u : 0u; mine = (j == x) ? c : mine; }
        if (sum == G) break;
        __builtin_amdgcn_s_sleep(1);
        if ((++sp & 255u) == 0u) { if (xb_ld(&bar[XB_TMO])) break; if (sp > XB_SPIN_CAP) { atomicAdd(&bar[XB_TMO], 1u); break; } }
    }
    nloc = mine > 0u ? mine : 1u; nx = cnt > 0u ? cnt : 1u;
}

__device__ __forceinline__ void xcd_barrier(const XcdBarrier& b) {
    asm volatile("s_waitcnt vmcnt(0)" ::: "memory");
    __syncthreads();
    if (threadIdx.x == 0) {
        unsigned* bar = b.bar;
        __builtin_amdgcn_s_waitcnt(0);
        unsigned nloc = b.st[0], nx = b.st[1];
        if (nloc == 0u) { xcd_barrier_complete(bar, b.x, nloc, nx); b.st[0] = nloc; b.st[1] = nx; }
        const unsigned old = xb_add(&bar[XB_XSUB(b.x)], 1u);
        const unsigned gen = old / nloc;
        if (old + 1u == (gen + 1u) * nloc) {
            __builtin_amdgcn_fence(__ATOMIC_RELEASE, "agent");
            asm volatile("s_waitcnt vmcnt(0)" ::: "memory");
            const unsigned og = xb_add(&bar[XB_TOP], 1u);
            const unsigned tg = og / nx;
            if (og + 1u == (tg + 1u) * nx) xb_add(&bar[XB_TOPGEN], 1u);
            else XB_SPIN(xb_ld(&bar[XB_TOPGEN]) == tg, bar);
            __builtin_amdgcn_fence(__ATOMIC_ACQUIRE, "agent");
            xb_add(&bar[XB_XGEN(b.x)], 1u);
            asm volatile("s_waitcnt vmcnt(0)" ::: "memory");
        } else {
            XB_SPIN(xb_ld(&bar[XB_XGEN(b.x)]) == gen, bar);
            __builtin_amdgcn_fence(__ATOMIC_ACQUIRE, "agent");
            asm volatile("s_waitcnt vmcnt(0)" ::: "memory");
        }
    }
    __syncthreads();
}
struct Args { const float* in[25]; float* out; unsigned char* ws; };

template <int MODE>
__device__ __forceinline__ void transpose_item(const float* W, int K, int N, bf16_t* WT, LAS float* scr, int item, int lane) {
    const int nblk = (N + 31) / 32, kb = item / nblk, nb = item % nblk, k0 = 64 * kb, n0 = 32 * nb;
    const int col = n0 + (lane & 31);
#pragma unroll 8
    for (int i = 0; i < 32; ++i) { const int kk = 2 * i + (lane >> 5); scr[kk * 33 + (lane & 31)] = (col < N) ? W[(size_t)(k0 + kk) * N + col] : 0.f; }
    asm volatile("s_waitcnt lgkmcnt(0)" ::: "memory");
    const int c = lane & 7;
#pragma unroll
    for (int j = 0; j < 4; ++j) { const int n = (lane >> 3) + 8 * j; const LAS float* s = scr + (8 * c) * 33 + n;
        u32x4 o; o.x = pk2(s[0 * 33], s[1 * 33]); o.y = pk2(s[2 * 33], s[3 * 33]); o.z = pk2(s[4 * 33], s[5 * 33]); o.w = pk2(s[6 * 33], s[7 * 33]);
        int src = n0 + n, dst = src;
        if (MODE == 1) { const int nf = src >= DFF ? 1 : 0; const int uu = src - nf * DFF; dst = (uu >> 2) * 8 + nf * 4 + (uu & 3); }
        *(u32x4*)(WT + (size_t)dst * K + k0 + 8 * c) = o; }
    asm volatile("s_waitcnt lgkmcnt(0)" ::: "memory");
}
__device__ __forceinline__ void convert_layer(const Args& a, int l, LAS unsigned char* lds) {
    int tid_l = threadIdx.x; asm volatile("" : "+v"(tid_l)); const int tid = tid_l, lane = tid & 63, wave = __builtin_amdgcn_readfirstlane(tid >> 6); const int gw = blockIdx.x * NWAVES + wave, NGW = gridDim.x * NWAVES; (void)gw; (void)NGW; (void)lane; (void)wave;
    LAS float* scr = (LAS float*)(lds + wave * 16384);
    unsigned char* ws = a.ws;
    constexpr int I_GU = (D / 64) * (NGU / 32), I_D = (DFF / 64) * (D / 32), I_IN = (D / 64) * ((DIN + 31) / 32), I_OUT = (D / 64) * (D / 32);
    constexpr int NIT = 2 * I_GU + 2 * I_D + I_IN + I_OUT;
    for (int it = gw; it < NIT; it += NGW) {
        int r = it;
        if (r < I_GU) { transpose_item<1>(a.in[1] + (size_t)l * D * NGU, D, NGU, (bf16_t*)(ws + WS_WGU1), scr, r, lane); continue; } r -= I_GU;
        if (r < I_GU) { transpose_item<1>(a.in[21] + (size_t)l * D * NGU, D, NGU, (bf16_t*)(ws + WS_WGU2), scr, r, lane); continue; } r -= I_GU;
        if (r < I_D) { transpose_item<0>(a.in[2] + (size_t)l * DFF * D, DFF, D, (bf16_t*)(ws + WS_WD1), scr, r, lane); continue; } r -= I_D;
        if (r < I_D) { transpose_item<0>(a.in[22] + (size_t)l * DFF * D, DFF, D, (bf16_t*)(ws + WS_WD2), scr, r, lane); continue; } r -= I_D;
        if (r < I_IN) { transpose_item<0>(a.in[5] + (size_t)l * D * DIN, D, DIN, (bf16_t*)(ws + WS_WIN), scr, r, lane); continue; } r -= I_IN;
        transpose_item<0>(a.in[18] + (size_t)l * D * D, D, D, (bf16_t*)(ws + WS_WOUT), scr, r, lane);
    }
}

__device__ __forceinline__ void ln_rows(float* X, const float* g, const float* b, bf16_t* XN) {
    int tid_l = threadIdx.x; asm volatile("" : "+v"(tid_l)); const int tid = tid_l, lane = tid & 63, wave = __builtin_amdgcn_readfirstlane(tid >> 6); const int gw = blockIdx.x * NWAVES + wave, NGW = gridDim.x * NWAVES; (void)gw; (void)NGW; (void)lane; (void)wave;
    f32x4 gv[4], bv[4];
#pragma unroll
    for (int j = 0; j < 4; ++j) { gv[j] = ((const f32x4*)g)[lane + 64 * j]; bv[j] = ((const f32x4*)b)[lane + 64 * j]; }
    for (int m = gw; m < M; m += NGW) {
        f32x4* xr = (f32x4*)(X + (size_t)m * D) + lane;
        f32x4 v[4]; float s = 0.f;
#pragma unroll
        for (int j = 0; j < 4; ++j) { v[j] = xr[64 * j]; s += (v[j].x + v[j].y) + (v[j].z + v[j].w); }
        const float mean = wave_sum(s) * (1.f / D); float s2 = 0.f;
#pragma unroll
        for (int j = 0; j < 4; ++j) { v[j] = v[j] - mean; s2 += (v[j].x * v[j].x + v[j].y * v[j].y) + (v[j].z * v[j].z + v[j].w * v[j].w); }
        const float rstd = rsqrtf(wave_sum(s2) * (1.f / D) + LN_EPS);
        u32x2* o8 = (u32x2*)(XN + (size_t)m * D) + lane;
#pragma unroll
        for (int j = 0; j < 4; ++j) { const f32x4 y = v[j] * rstd * gv[j] + bv[j]; xr[64 * j] = y; u32x2 w; w.x = pk2(y.x, y.y); w.y = pk2(y.z, y.w); o8[64 * j] = w; }
    }
}

__device__ __forceinline__ void prologue(const Args& a) {
    int tid_l = threadIdx.x; asm volatile("" : "+v"(tid_l)); const int tid = tid_l, lane = tid & 63, wave = __builtin_amdgcn_readfirstlane(tid >> 6); const int gw = blockIdx.x * NWAVES + wave, NGW = gridDim.x * NWAVES; (void)gw; (void)NGW; (void)lane; (void)wave;
    float* rope = (float*)(a.ws + WS_ROPE);
    const int gt = gw * 64 + lane;
    if (gt < 4096 * 4) {
        const int pos = gt >> 2, i = gt & 3;
        const float invf = (i == 0) ? 1.0f : (i == 1) ? 0.03760603070259094f : (i == 2) ? 0.0014142135623842478f : 5.3182957344688475e-05f;
        const float ang = (float)pos * invf;
        const double x = (double)ang; const double k = rint(x * 0.15915494309189535); const double r = x - k * 6.283185307179586;
        const double r2 = r * r; double sn = 1.0, cs = 1.0, ts = 1.0, tc = 1.0;
#pragma unroll
        for (int n = 1; n <= 12; ++n) { tc *= -r2 / (double)((2 * n - 1) * (2 * n)); ts *= -r2 / (double)((2 * n) * (2 * n + 1)); cs += tc; sn += ts; }
        sn *= r;
        rope[gt * 2] = (float)cs; rope[gt * 2 + 1] = (float)sn;
    }
    const float* x = a.in[0]; float* X = a.out; bf16_t* XN = (bf16_t*)(a.ws + WS_XN);
    for (int m = gw; m < M; m += NGW) {
        const f32x4* xr = (const f32x4*)(x + (size_t)m * D) + lane; f32x4* o = (f32x4*)(X + (size_t)m * D) + lane; u32x2* o8 = (u32x2*)(XN + (size_t)m * D) + lane;
#pragma unroll
        for (int j = 0; j < 4; ++j) { const f32x4 v = xr[64 * j]; o[64 * j] = v; u32x2 w; w.x = pk2(v.x, v.y); w.y = pk2(v.z, v.w); o8[64 * j] = w; }
    }
}

__device__ __forceinline__ void prep_phase(const Args& a, int l, LAS unsigned char* lds) {
    int tid_l = threadIdx.x; asm volatile("" : "+v"(tid_l)); const int tid = tid_l, lane = tid & 63, wave = __builtin_amdgcn_readfirstlane(tid >> 6); const int gw = blockIdx.x * NWAVES + wave, NGW = gridDim.x * NWAVES; (void)gw; (void)NGW; (void)lane; (void)wave;
    const bf16_t* Hb = (const bf16_t*)(a.ws + WS_HB); bf16_t* XC = (bf16_t*)(a.ws + WS_XC); bf16_t* GQ = (bf16_t*)(a.ws + WS_GQ); float* SC = (float*)(a.ws + WS_SC);
    const float* mcw = a.in[8] + (size_t)l * 4 * 1024; const float* mcb = a.in[9] + (size_t)l * 1024;
    const float* mdtb = a.in[10] + l * 8; const float* mAl = a.in[11] + l * 8;
    const float* gcw = a.in[14] + (size_t)l * 4 * 768; const float* gAl = a.in[15] + l * 4; const float* gdtb = a.in[16] + l * 4;
    LAS float* qk = (LAS float*)lds;
    for (int blk = blockIdx.x; blk < M / 64; blk += gridDim.x) {
        const int row0 = blk * 64; const bool has_halo = (row0 & (SEQ - 1)) != 0;
        {
            const int ch = 2 * tid; const int col = C_MXBC + ch;
            float w[4][2], bias[2];
#pragma unroll
            for (int k = 0; k < 4; ++k) { w[k][0] = mcw[k * 1024 + ch]; w[k][1] = mcw[k * 1024 + ch + 1]; }
            bias[0] = mcb[ch]; bias[1] = mcb[ch + 1];
            float xm[3][2];
#pragma unroll
            for (int k = 0; k < 3; ++k) { unsigned u = 0; if (has_halo) u = *(const unsigned*)(Hb + (size_t)(row0 - 3 + k) * DINP + col); xm[k][0] = bf2f(u & 0xffffu); xm[k][1] = bf2f(u >> 16); }
#pragma unroll 4
            for (int r = 0; r < 64; ++r) {
                const unsigned u = *(const unsigned*)(Hb + (size_t)(row0 + r) * DINP + col); const float x0 = bf2f(u & 0xffffu), x1 = bf2f(u >> 16);
                const float a0 = w[0][0] * xm[0][0] + w[1][0] * xm[1][0] + w[2][0] * xm[2][0] + w[3][0] * x0 + bias[0];
                const float a1 = w[0][1] * xm[0][1] + w[1][1] * xm[1][1] + w[2][1] * xm[2][1] + w[3][1] * x1 + bias[1];
                *(unsigned*)(XC + (size_t)(row0 + r) * 1024 + ch) = pk2(silu_f(a0), silu_f(a1));
                xm[0][0] = xm[1][0]; xm[1][0] = xm[2][0]; xm[2][0] = x0; xm[0][1] = xm[1][1]; xm[1][1] = xm[2][1]; xm[2][1] = x1;
            }
        }
        if (tid < 384) {
            const int ch = 2 * tid; const int col = C_GQ + ch;
            float w[4][2];
#pragma unroll
            for (int k = 0; k < 4; ++k) { w[k][0] = gcw[k * 768 + ch]; w[k][1] = gcw[k * 768 + ch + 1]; }
            float xm[3][2];
#pragma unroll
            for (int k = 0; k < 3; ++k) { unsigned u = 0; if (has_halo) u = *(const unsigned*)(Hb + (size_t)(row0 - 3 + k) * DINP + col); xm[k][0] = bf2f(u & 0xffffu); xm[k][1] = bf2f(u >> 16); }
#pragma unroll 4
            for (int r = 0; r < 64; ++r) {
                const unsigned u = *(const unsigned*)(Hb + (size_t)(row0 + r) * DINP + col); const float x0 = bf2f(u & 0xffffu), x1 = bf2f(u >> 16);
                const float a0 = silu_f(w[0][0] * xm[0][0] + w[1][0] * xm[1][0] + w[2][0] * xm[2][0] + w[3][0] * x0);
                const float a1 = silu_f(w[0][1] * xm[0][1] + w[1][1] * xm[1][1] + w[2][1] * xm[2][1] + w[3][1] * x1);
                if (ch < 512) { qk[r * 512 + ch] = a0; qk[r * 512 + ch + 1] = a1; }
                else *(unsigned*)(GQ + (size_t)(row0 + r) * 768 + ch) = pk2(a0, a1);
                xm[0][0] = xm[1][0]; xm[1][0] = xm[2][0]; xm[2][0] = x0; xm[0][1] = xm[1][1]; xm[1][1] = xm[2][1]; xm[2][1] = x1;
            }
        } else {
            for (int it = tid - 384; it < 64 * 16; it += 128) {
                const int r = it >> 4, j = it & 15; const size_t row = row0 + r; const bf16_t* hr = Hb + row * DINP; float* sc = SC + row * 32;
                if (j < 8) { const float dt = softplus_f(bf2f(hr[C_MDT + j]) + mdtb[j]); sc[j] = dt; sc[8 + j] = __expf(-dt * __expf(mAl[j])); }
                else if (j < 12) { const int hh = j - 8; sc[16 + hh] = sigmoid_f(bf2f(hr[C_GB + hh])); }
                else { const int hh = j - 12; const float g = -__expf(gAl[hh]) * softplus_f(bf2f(hr[C_GA + hh]) + gdtb[hh]); sc[20 + hh] = __expf(g); }
            }
        }
        __syncthreads();
        for (int it = wave * 64; it < wave * 64 + 64; ++it) {
            const int r = it >> 3, hd = it & 7; const float v = qk[r * 512 + hd * 64 + lane];
            const float ss = wave_sum(v * v); const float sc = rsqrtf(ss + 1e-6f) * (hd < 4 ? 0.125f : 1.0f);
            GQ[(size_t)(row0 + r) * 768 + hd * 64 + lane] = (bf16_t)f2bf(v * sc);
        }
        __syncthreads();
    }
}

__device__ __forceinline__ void mamba_task(const Args& a, int task, int lane) {
    const bf16_t* XC = (const bf16_t*)(a.ws + WS_XC); const float* SC = (const float*)(a.ws + WS_SC); float* YM = (float*)(a.ws + WS_YM);
    const int b = task >> 8, h = (task >> 5) & 7, pp = task & 31, g = h >> 2;
    const size_t rowb = (size_t)b * SEQ;
    const unsigned* Bp = (const unsigned*)(XC + rowb * 1024 + 512 + g * 128) + lane;
    const unsigned* Cp = (const unsigned*)(XC + rowb * 1024 + 768 + g * 128) + lane;
    const unsigned* Xp = (const unsigned*)(XC + rowb * 1024 + h * 64 + 2 * pp);
    const float* Sp = SC + rowb * 32 + h;
    float* Yp = YM + rowb * 512 + h * 64 + 2 * pp;
    constexpr int T = 8;
    unsigned Bn[T], Cn[T], Xn[T]; float dtn[T], dAn[T];
#pragma unroll
    for (int i = 0; i < T; ++i) { Bn[i] = Bp[(size_t)i * 512]; Cn[i] = Cp[(size_t)i * 512]; Xn[i] = Xp[(size_t)i * 512]; dtn[i] = Sp[(size_t)i * 32]; dAn[i] = Sp[(size_t)i * 32 + 8]; }
    float h00 = 0.f, h01 = 0.f, h10 = 0.f, h11 = 0.f;
    for (int t0 = 0; t0 < SEQ; t0 += T) {
        unsigned Bc[T], Cc[T], Xc[T]; float dtc[T], dAc[T];
#pragma unroll
        for (int i = 0; i < T; ++i) { Bc[i] = Bn[i]; Cc[i] = Cn[i]; Xc[i] = Xn[i]; dtc[i] = dtn[i]; dAc[i] = dAn[i]; }
        if (t0 + T < SEQ) {
#pragma unroll
            for (int i = 0; i < T; ++i) { const size_t t = t0 + T + i; Bn[i] = Bp[t * 512]; Cn[i] = Cp[t * 512]; Xn[i] = Xp[t * 512]; dtn[i] = Sp[t * 32]; dAn[i] = Sp[t * 32 + 8]; }
        }
#pragma unroll
        for (int i = 0; i < T; ++i) {
            const float B0 = bf2f(Bc[i] & 0xffffu), B1 = bf2f(Bc[i] >> 16), C0 = bf2f(Cc[i] & 0xffffu), C1 = bf2f(Cc[i] >> 16);
            const float x0 = bf2f(Xc[i] & 0xffffu) * dtc[i], x1 = bf2f(Xc[i] >> 16) * dtc[i]; const float dA = dAc[i];
            h00 = h00 * dA + x0 * B0; h01 = h01 * dA + x0 * B1; h10 = h10 * dA + x1 * B0; h11 = h11 * dA + x1 * B1;
            const float y0 = wave_sum(C0 * h00 + C1 * h01), y1 = wave_sum(C0 * h10 + C1 * h11);
            if (lane == 0) { f32x2 yy = {y0, y1}; *(f32x2*)(Yp + (size_t)(t0 + i) * 512) = yy; }
        }
    }
}
__device__ __forceinline__ void delta_task(const Args& a, int task, int lane) {
    const bf16_t* GQ = (const bf16_t*)(a.ws + WS_GQ); const float* SC = (const float*)(a.ws + WS_SC); float* OD = (float*)(a.ws + WS_OD);
    const int b = task >> 8, hh = (task >> 6) & 3, dv = task & 63;
    const size_t rowb = (size_t)b * SEQ;
    const bf16_t* Qp = GQ + rowb * 768 + hh * 64 + lane; const bf16_t* Kp = Qp + 256; const bf16_t* Vp = GQ + rowb * 768 + 512 + hh * 64 + dv;
    const float* Sp = SC + rowb * 32 + 16 + hh; float* Op = OD + rowb * 256 + hh * 64 + dv;
    constexpr int T = 8;
    unsigned short qn[T], kn[T], vn_[T]; float btn[T], dcn[T];
#pragma unroll
    for (int i = 0; i < T; ++i) { qn[i] = Qp[(size_t)i * 768]; kn[i] = Kp[(size_t)i * 768]; vn_[i] = Vp[(size_t)i * 768]; btn[i] = Sp[(size_t)i * 32]; dcn[i] = Sp[(size_t)i * 32 + 4]; }
    float S = 0.f;
    for (int t0 = 0; t0 < SEQ; t0 += T) {
        unsigned short qc[T], kc[T], vc[T]; float btc[T], dcc[T];
#pragma unroll
        for (int i = 0; i < T; ++i) { qc[i] = qn[i]; kc[i] = kn[i]; vc[i] = vn_[i]; btc[i] = btn[i]; dcc[i] = dcn[i]; }
        if (t0 + T < SEQ) {
#pragma unroll
            for (int i = 0; i < T; ++i) { const size_t t = t0 + T + i; qn[i] = Qp[t * 768]; kn[i] = Kp[t * 768]; vn_[i] = Vp[t * 768]; btn[i] = Sp[t * 32]; dcn[i] = Sp[t * 32 + 4]; }
        }
#pragma unroll
        for (int i = 0; i < T; ++i) {
            const float q = bf2f(qc[i]), k = bf2f(kc[i]), v = bf2f(vc[i]), beta = btc[i], dec = dcc[i];
            const float ks = wave_sum(S * k);
            const float vnew = beta * (v - dec * ks);
            S = S * dec + k * vnew;
            const float o = wave_sum(S * q);
            if (lane == 0) Op[(size_t)(t0 + i) * 256] = o;
        }
    }
}

constexpr int AT_K = 0, AT_V = 16384, AT_WS = 16384 + 17408, AT_OST = AT_WS + 1024, AT_END = AT_OST + 8 * 32 * 65 * 4;
static_assert(AT_END <= 131072, "attention LDS");
__device__ __forceinline__ void attn_unit(const Args& a, int l, int b, int h, int qb, float lam, float lam_init, LAS unsigned char* lds) {
    int tid_l = threadIdx.x; asm volatile("" : "+v"(tid_l)); const int tid = tid_l, lane = tid & 63, wid = __builtin_amdgcn_readfirstlane(tid >> 6), r32 = lane & 31, hi = lane >> 5, map = wid >> 2, wq = wid & 3;
    const bf16_t* Hb = (const bf16_t*)(a.ws + WS_HB); bf16_t* MIX = (bf16_t*)(a.ws + WS_MIX);
    const size_t rowb = (size_t)b * SEQ; const int q0 = qb * 128;
    bf16x8 qr[2];
    { const bf16_t* qp = Hb + (rowb + q0 + wq * 32 + r32) * DINP + C_DQ + h * 64 + map * 32 + hi * 8; qr[0] = *(const bf16x8*)qp; qr[1] = *(const bf16x8*)(qp + 16); }
    const int NT = 2 * qb + 2; const int my_last = 2 * qb + (wq >> 1);
    const int kmap = tid >> 8, kkv = (tid & 255) >> 2, kc = tid & 3;
    const bf16_t* ksrc = Hb + (rowb + kkv) * DINP + C_DK + h * 64 + kmap * 32 + kc * 8;
    const int kdst = AT_K + kmap * 4096 + ((((kc >> 1) * 2 + (kkv >> 5)) * 2 + (kc & 1)) * 512) + (kkv & 31) * 16;
    const bf16_t* vsrc = Hb + (rowb + lane) * DINP + C_DV + h * 64 + wid * 8;
    const int vdst = AT_V + ((wid * 8) * 68 + lane) * 2;
    u32x4 kreg = *(const u32x4*)ksrc, vreg = *(const u32x4*)vsrc;
#define AT_WRITE(buf) do { *(LAS u32x4*)(lds + (buf) * 8192 + kdst) = kreg; LAS unsigned short* vp_ = (LAS unsigned short*)(lds + (buf) * 8704 + vdst); \
        vp_[0 * 68] = (unsigned short)(vreg.x & 0xffffu); vp_[1 * 68] = (unsigned short)(vreg.x >> 16); vp_[2 * 68] = (unsigned short)(vreg.y & 0xffffu); vp_[3 * 68] = (unsigned short)(vreg.y >> 16); \
        vp_[4 * 68] = (unsigned short)(vreg.z & 0xffffu); vp_[5 * 68] = (unsigned short)(vreg.z >> 16); vp_[6 * 68] = (unsigned short)(vreg.w & 0xffffu); vp_[7 * 68] = (unsigned short)(vreg.w >> 16); } while (0)
    AT_WRITE(0);
    __syncthreads();
    float m_run = -INFINITY, l_run = 0.f; f32x16 o0 = {}, o1 = {};
    LAS float* wsf = (LAS float*)(lds + AT_WS) + wid * 32;
    const float c = 0.25503486164919736f;
    for (int t = 0; t < NT; ++t) {
        if (t + 1 < NT) { kreg = *(const u32x4*)(ksrc + (size_t)(t + 1) * 64 * DINP); vreg = *(const u32x4*)(vsrc + (size_t)(t + 1) * 64 * DINP); }
        if (t <= my_last) {
            const int buf = t & 1;
            const LAS unsigned char* Kb = lds + buf * 8192 + AT_K + map * 4096;
            f32x16 p0 = {}, p1 = {};
#pragma unroll
            for (int d0 = 0; d0 < 2; ++d0) {
                const bf16x8 a0 = *(const LAS bf16x8*)(Kb + ((d0 * 2 + 0) * 2 + hi) * 512 + r32 * 16);
                const bf16x8 a1 = *(const LAS bf16x8*)(Kb + ((d0 * 2 + 1) * 2 + hi) * 512 + r32 * 16);
                p0 = __builtin_amdgcn_mfma_f32_32x32x16_bf16(a0, qr[d0], p0, 0, 0, 0);
                p1 = __builtin_amdgcn_mfma_f32_32x32x16_bf16(a1, qr[d0], p1, 0, 0, 0);
            }
            float mx = p0[0];
#pragma unroll
            for (int r = 1; r < 16; ++r) mx = fmaxf(mx, p0[r]);
#pragma unroll
            for (int r = 0; r < 16; ++r) mx = fmaxf(mx, p1[r]);
            mx = fmaxf(mx, xor32(mx));
            const float m_new = fmaxf(m_run, mx * c);
            const float alpha = exp2f(m_run - m_new);
            m_run = m_new;
            float rs = 0.f;
#pragma unroll
            for (int r = 0; r < 16; ++r) { p0[r] = exp2f(p0[r] * c - m_new); rs += p0[r]; }
#pragma unroll
            for (int r = 0; r < 16; ++r) { p1[r] = exp2f(p1[r] * c - m_new); rs += p1[r]; }
            l_run = l_run * alpha + rs;
            if (__any(alpha != 1.0f)) {
                if (hi == 0) wsf[r32] = alpha;
                asm volatile("s_waitcnt lgkmcnt(0)" ::: "memory");
#pragma unroll
                for (int r = 0; r < 16; ++r) { const float f = wsf[(r & 3) + 8 * (r >> 2) + 4 * hi]; o0[r] *= f; o1[r] *= f; }
            }
            bf16x8 pa[4];
#pragma unroll
            for (int ks = 0; ks < 4; ++ks) { u32x4 w;
                if (ks < 2) { const int o = 8 * ks; w.x = pk2(p0[o], p0[o + 1]); w.y = pk2(p0[o + 2], p0[o + 3]); w.z = pk2(p0[o + 4], p0[o + 5]); w.w = pk2(p0[o + 6], p0[o + 7]); }
                else { const int o = 8 * (ks - 2); w.x = pk2(p1[o], p1[o + 1]); w.y = pk2(p1[o + 2], p1[o + 3]); w.z = pk2(p1[o + 4], p1[o + 5]); w.w = pk2(p1[o + 6], p1[o + 7]); }
                pa[ks] = __builtin_bit_cast(bf16x8, w); }
            const LAS unsigned char* Vb = lds + buf * 8704 + AT_V;
#pragma unroll
            for (int ks = 0; ks < 4; ++ks) { const int kvb = 16 * (ks & 1) + 32 * (ks >> 1) + 4 * hi;
                { const LAS unsigned char* vp = Vb + (r32 * 68 + kvb) * 2; const u32x2 lo = *(const LAS u32x2*)vp, hh2 = *(const LAS u32x2*)(vp + 16);
                  u32x4 w = {lo.x, lo.y, hh2.x, hh2.y}; o0 = __builtin_amdgcn_mfma_f32_32x32x16_bf16(pa[ks], __builtin_bit_cast(bf16x8, w), o0, 0, 0, 0); }
                { const LAS unsigned char* vp = Vb + ((32 + r32) * 68 + kvb) * 2; const u32x2 lo = *(const LAS u32x2*)vp, hh2 = *(const LAS u32x2*)(vp + 16);
                  u32x4 w = {lo.x, lo.y, hh2.x, hh2.y}; o1 = __builtin_amdgcn_mfma_f32_32x32x16_bf16(pa[ks], __builtin_bit_cast(bf16x8, w), o1, 0, 0, 0); }
            }
        }
        if (t + 1 < NT) AT_WRITE((t + 1) & 1);
        __syncthreads();
    }
#undef AT_WRITE
    { const float lt = l_run + xor32(l_run);
      if (hi == 0) wsf[r32] = 1.0f / lt;
      asm volatile("s_waitcnt lgkmcnt(0)" ::: "memory");
      LAS float* ost = (LAS float*)(lds + AT_OST) + wid * (32 * 65);
#pragma unroll
      for (int r = 0; r < 16; ++r) { const int q = (r & 3) + 8 * (r >> 2) + 4 * hi; const float f = wsf[q]; ost[q * 65 + r32] = o0[r] * f; ost[q * 65 + 32 + r32] = o1[r] * f; } }
    __syncthreads();
    if (wid < 4) {
        const int q = lane >> 1, dh = lane & 1;
        const LAS float* o1p = (const LAS float*)(lds + AT_OST) + wid * (32 * 65) + q * 65 + dh * 32; const LAS float* o2p = o1p + 4 * (32 * 65);
        const float* sw = a.in[7] + l * 64 + dh * 32;
        float v[32]; float ss = 0.f;
#pragma unroll
        for (int e = 0; e < 32; ++e) { v[e] = o1p[e] - lam * o2p[e]; ss += v[e] * v[e]; }
        ss += dpp_mov<0xB1>(ss);
        const float rinv = rsqrtf(ss * (1.f / 64.f) + LN_EPS) * (1.f - lam_init);
        bf16_t* op = MIX + (rowb + q0 + wid * 32 + q) * 1024 + h * 64 + dh * 32;
#pragma unroll
        for (int e8 = 0; e8 < 4; ++e8) { u32x4 w; const int e = e8 * 8;
            w.x = pk2(v[e] * rinv * sw[e], v[e + 1] * rinv * sw[e + 1]); w.y = pk2(v[e + 2] * rinv * sw[e + 2], v[e + 3] * rinv * sw[e + 3]);
            w.z = pk2(v[e + 4] * rinv * sw[e + 4], v[e + 5] * rinv * sw[e + 5]); w.w = pk2(v[e + 6] * rinv * sw[e + 6], v[e + 7] * rinv * sw[e + 7]);
            *(u32x4*)(op + e) = w; }
    }
    __syncthreads();
}

__device__ __forceinline__ void post_phase(const Args& a, int l) {
    int tid_l = threadIdx.x; asm volatile("" : "+v"(tid_l)); const int tid = tid_l, lane = tid & 63, wave = __builtin_amdgcn_readfirstlane(tid >> 6); const int gw = blockIdx.x * NWAVES + wave, NGW = gridDim.x * NWAVES; (void)gw; (void)NGW; (void)lane; (void)wave;
    const bf16_t* Hb = (const bf16_t*)(a.ws + WS_HB); const bf16_t* XC = (const bf16_t*)(a.ws + WS_XC); const float* YM = (const float*)(a.ws + WS_YM); const float* OD = (const float*)(a.ws + WS_OD);
    bf16_t* MIX = (bf16_t*)(a.ws + WS_MIX);
    const float Dh = a.in[12][l * 8 + (lane >> 3)];
    f32x4 nw0 = *(const f32x4*)(a.in[13] + l * 512 + 8 * lane), nw1 = *(const f32x4*)(a.in[13] + l * 512 + 8 * lane + 4);
    const f32x4 gw4 = *(const f32x4*)(a.in[17] + l * 64 + 4 * (lane & 15));
    for (int row = gw; row < M; row += NGW) {
        {   const f32x4 y0 = *(const f32x4*)(YM + (size_t)row * 512 + 8 * lane), y1 = *(const f32x4*)(YM + (size_t)row * 512 + 8 * lane + 4);
            const u32x4 xc = *(const u32x4*)(XC + (size_t)row * 1024 + 8 * lane); const u32x4 z = *(const u32x4*)(Hb + (size_t)row * DINP + C_MZ + 8 * lane);
            float y[8] = {y0[0], y0[1], y0[2], y0[3], y1[0], y1[1], y1[2], y1[3]}; const unsigned xw[4] = {xc.x, xc.y, xc.z, xc.w}, zw[4] = {z.x, z.y, z.z, z.w};
            float ss = 0.f;
#pragma unroll
            for (int j = 0; j < 4; ++j) { y[2 * j] = (y[2 * j] + Dh * bf2f(xw[j] & 0xffffu)) * silu_f(bf2f(zw[j] & 0xffffu)); y[2 * j + 1] = (y[2 * j + 1] + Dh * bf2f(xw[j] >> 16)) * silu_f(bf2f(zw[j] >> 16));
                ss += y[2 * j] * y[2 * j] + y[2 * j + 1] * y[2 * j + 1]; }
            ss += dpp_mov<0xB1>(ss); ss += dpp_mov<0x4E>(ss); ss += dpp_mov<0x141>(ss); ss += dpp_mov<0x140>(ss);
            { auto rr = __builtin_amdgcn_permlane16_swap(__float_as_uint(ss), __float_as_uint(ss), false, false); ss = __uint_as_float(rr[0]) + __uint_as_float(rr[1]); }
            const float r = rsqrtf(ss * (1.f / 256.f) + LN_EPS);
            u32x4 w; w.x = pk2(y[0] * r * nw0[0], y[1] * r * nw0[1]); w.y = pk2(y[2] * r * nw0[2], y[3] * r * nw0[3]); w.z = pk2(y[4] * r * nw1[0], y[5] * r * nw1[1]); w.w = pk2(y[6] * r * nw1[2], y[7] * r * nw1[3]);
            *(u32x4*)(MIX + (size_t)row * 1024 + 256 + 8 * lane) = w; }
        {   const f32x4 o = *(const f32x4*)(OD + (size_t)row * 256 + 4 * lane); const u32x2 gz = *(const u32x2*)(Hb + (size_t)row * DINP + C_GZ + 4 * lane);
            float ss = o[0] * o[0] + o[1] * o[1] + o[2] * o[2] + o[3] * o[3];
            ss += dpp_mov<0xB1>(ss); ss += dpp_mov<0x4E>(ss); ss += dpp_mov<0x141>(ss); ss += dpp_mov<0x140>(ss);
            const float r = rsqrtf(ss * (1.f / 64.f) + LN_EPS);
            u32x2 w; w.x = pk2(o[0] * r * gw4[0] * silu_f(bf2f(gz.x & 0xffffu)), o[1] * r * gw4[1] * silu_f(bf2f(gz.x >> 16)));
            w.y = pk2(o[2] * r * gw4[2] * silu_f(bf2f(gz.y & 0xffffu)), o[3] * r * gw4[3] * silu_f(bf2f(gz.y >> 16)));
            *(u32x2*)(MIX + (size_t)row * 1024 + 768 + 4 * lane) = w; }
    }
}
#ifndef REP_REC
#define REP_REC 1
#endif
#ifndef REP_ATTN
#define REP_ATTN 1
#endif
#ifndef REP_SYNC
#define REP_SYNC 1
#endif
#define GSYNC() do { for (int rs_ = 0; rs_ < REP_SYNC; ++rs_) xcd_barrier(bar); } while (0)
__global__ void __launch_bounds__(512, 2) fwd_megakernel(Args a) {
    extern __shared__ __attribute__((aligned(16))) unsigned char lds_raw[];
    LAS unsigned char* lds = (LAS unsigned char*)lds_raw;
    cg::grid_group grid = cg::this_grid();
    const int G = gridDim.x;
    unsigned char* ws = a.ws;
    float* X = a.out; bf16_t* XN = (bf16_t*)(ws + WS_XN); bf16_t* HB = (bf16_t*)(ws + WS_HB); bf16_t* MIX = (bf16_t*)(ws + WS_MIX);
    const float beta_half = 0.5f;

    for (int u = threadIdx.x; u < 64; u += 512) ((LAS unsigned*)(lds + 131072))[u] = 0u;
    __syncthreads();
    XcdBarrier bar = xcd_barrier_post((unsigned*)a.ws, (volatile LAS unsigned*)(lds + 131072) + 8);
#ifndef NO_PRO
    prologue(a);
    convert_layer(a, 0, lds);
#endif
    grid.sync();

    for (int l = 0; l < DEPTH; ++l) {
        { pg8::Gemm g{XN, (const bf16_t*)(ws + WS_WGU1), M, NGU, D}; pg8::StaticOrder S; S.init(M, NGU, G, (int)blockIdx.x); pg8::EpiSwiglu E{HB};
          pg8::gemm_phase<pg8::EpiSwiglu, pg8::StaticOrder, true, true>(lds, g, S, E); }
        GSYNC();
        { pg8::Gemm g{HB, (const bf16_t*)(ws + WS_WD1), M, D, DFF}; pg8::StaticOrder S; S.init(M, D, G, (int)blockIdx.x); pg8::EpiResid E{X, ALPHA, beta_half};
          pg8::gemm_phase<pg8::EpiResid, pg8::StaticOrder, true, true>(lds, g, S, E); }
        GSYNC();
        ln_rows(X, a.in[3] + l * D, a.in[4] + l * D, XN);
        GSYNC();
        { pg8::Gemm g{XN, (const bf16_t*)(ws + WS_WIN), M, DINP, D}; pg8::StaticOrder S; S.init(M, DINP, G, (int)blockIdx.x); pg8::EpiInproj E{HB, (const float*)(ws + WS_ROPE)};
          pg8::gemm_phase<pg8::EpiInproj, pg8::StaticOrder, true, true>(lds, g, S, E); }
        GSYNC();
#ifndef NO_PREP
        prep_phase(a, l, lds);
#endif
        GSYNC();
        {
            int tid_l = threadIdx.x; asm volatile("" : "+v"(tid_l)); const int lane = tid_l & 63, wave = __builtin_amdgcn_readfirstlane(tid_l >> 6);
            for (int rep_ = 0; rep_ < REP_REC; ++rep_)
            for (int tb = blockIdx.x; tb < 256; tb += G) {
#ifndef NO_REC
                if (wave < 4) mamba_task(a, tb * 4 + wave, lane); else delta_task(a, tb * 4 + (wave - 4), lane);
#endif
            }
            __syncthreads();
            const float* lp = a.in[6] + l * 128; float d1 = 0.f, d2 = 0.f;
            for (int i = 0; i < 32; ++i) { d1 += lp[i] * lp[32 + i]; d2 += lp[64 + i] * lp[96 + i]; }
            const float lam_init = 0.8f - 0.6f * __expf(-0.3f * (float)l);
            const float lam = __expf(d1) - __expf(d2) + lam_init;
            for (int rep_ = 0; rep_ < REP_ATTN; ++rep_)
            for (int u = blockIdx.x; u < 512; u += G) {
                const int j = u >> 8, v = u & 255, bh = v >> 4, s = v & 15, qb = j == 0 ? s : 31 - s;
#ifndef NO_ATTN
                attn_unit(a, l, bh >> 2, bh & 3, qb, lam, lam_init, lds);
#endif
            }
        }
        GSYNC();
#ifndef NO_POST
        post_phase(a, l);
#endif
        GSYNC();
        { pg8::Gemm g{MIX, (const bf16_t*)(ws + WS_WOUT), M, D, D}; pg8::StaticOrder S; S.init(M, D, G, (int)blockIdx.x); pg8::EpiResid E{X, ALPHA, 1.0f};
          pg8::gemm_phase<pg8::EpiResid, pg8::StaticOrder, true, true>(lds, g, S, E); }
        GSYNC();
        ln_rows(X, a.in[19] + l * D, a.in[20] + l * D, XN);
        GSYNC();
        { pg8::Gemm g{XN, (const bf16_t*)(ws + WS_WGU2), M, NGU, D}; pg8::StaticOrder S; S.init(M, NGU, G, (int)blockIdx.x); pg8::EpiSwiglu E{HB};
          pg8::gemm_phase<pg8::EpiSwiglu, pg8::StaticOrder, true, true>(lds, g, S, E); }
        GSYNC();
        { pg8::Gemm g{HB, (const bf16_t*)(ws + WS_WD2), M, D, DFF}; pg8::StaticOrder S; S.init(M, D, G, (int)blockIdx.x); pg8::EpiResid E{X, ALPHA, beta_half};
          pg8::gemm_phase<pg8::EpiResid, pg8::StaticOrder, true, true>(lds, g, S, E); }
        GSYNC();
        ln_rows(X, a.in[23] + l * D, a.in[24] + l * D, XN);
#ifndef NO_PRO
        if (l + 1 < DEPTH) convert_layer(a, l + 1, lds);
#endif
        GSYNC();
    }
}

extern "C" void kernel_launch(void* const* d_in, const int* in_sizes, int n_in, void* d_out, int out_size, void* d_ws, size_t ws_size, hipStream_t stream) {
    static int grid = 0;
    if (grid == 0) {
        if (n_in != 25 || out_size != M * D || ws_size < WS_END) { fprintf(stderr, "kernel_launch: unexpected shapes (n_in %d out %d ws %zu)\n", n_in, out_size, ws_size); grid = -1; return; }
        int dev = 0, cus = 0, per_cu = 0;
        hipGetDevice(&dev); hipDeviceGetAttribute(&cus, hipDeviceAttributeMultiprocessorCount, dev);
        if (hipFuncSetAttribute((const void*)fwd_megakernel, hipFuncAttributeMaxDynamicSharedMemorySize, LDS_BYTES) != hipSuccess) { fprintf(stderr, "kernel_launch: hipFuncSetAttribute failed\n"); grid = -1; return; }
        if (hipOccupancyMaxActiveBlocksPerMultiprocessor(&per_cu, (const void*)fwd_megakernel, 512, LDS_BYTES) != hipSuccess || per_cu < 1) { fprintf(stderr, "kernel_launch: occupancy query says %d\n", per_cu); per_cu = 1; }
        (void)hipGetLastError();
        grid = cus * per_cu; if (grid > 256) grid = 256;
    }
    if (grid < 0) return;
    if (hipMemsetAsync(d_ws, 0, 65536, stream) != hipSuccess) { fprintf(stderr, "kernel_launch: memset failed\n"); return; }
    Args a{};
    for (int i = 0; i < 25; ++i) a.in[i] = (const float*)d_in[i];
    a.out = (float*)d_out; a.ws = (unsigned char*)d_ws;
    void* args[] = {&a};
    hipError_t e = hipLaunchCooperativeKernel((const void*)fwd_megakernel, dim3(grid), dim3(512), args, LDS_BYTES, stream);
    if (e != hipSuccess) fprintf(stderr, "cooperative launch failed: %s (grid %d)\n", hipGetErrorString(e), grid);
}
```

```cpp
#include <hip/hip_runtime.h>
#include <hip/hip_cooperative_groups.h>
#include <cstdio>
#include <cstdint>
namespace cg = cooperative_groups;
namespace pg8 {
#define PG8_LAS __attribute__((address_space(3)))
typedef unsigned short bf16_t;
typedef short bf16x8 __attribute__((ext_vector_type(8)));
typedef float f32x4 __attribute__((ext_vector_type(4)));
typedef unsigned u32x4 __attribute__((ext_vector_type(4)));
constexpr int BM = 256, BK = 64, HALF = 128, HTB = HALF * BK * 2  , STAGE_BYTES = 8 * HTB, NXCD = 8, WGM = 8;

__host__ __device__ __forceinline__ int lds_byte(int r, int c) { const int st = (r >> 4) * 2 + (c >> 5), rr = r & 15, cc = c & 31, ob = rr * 64 + cc * 2; return st * 1024 + (ob ^ (((ob >> 9) & 1) << 5)); }
__host__ __device__ __forceinline__ void stage_rc(int b, int& R, int& C) { const int st = b / 1024, sb = b % 1024, swz = sb ^ (((sb >> 9) & 1) << 5); R = (st >> 1) * 16 + swz / 64; C = (st & 1) * 32 + (swz % 64) / 2; }
__host__ __device__ __forceinline__ int perm32(int rho) { const int n = rho >> 4, i = rho & 15; return 8 * (i >> 2) + 4 * n + (i & 3); }

struct Unit { int pm, pn; };
struct Gemm { const bf16_t* A; const bf16_t* Bt; int M, N, K; };

struct StaticOrder {
    int nM, nN, nwg, G, c;
    __host__ __device__ void init(int M, int N, int G_, int c_) { nM = M / BM; nN = N / BM; nwg = nM * nN; G = G_; c = c_; }
    __host__ __device__ bool next(int i, Unit& u) const {
        const long L = (long)i * G + c; if (L >= nwg) return false;
        int wgid = (int)L; { const int q = nwg / NXCD, r = nwg % NXCD, xcd = wgid % NXCD, off = wgid / NXCD; wgid = (xcd < r ? xcd * (q + 1) : r * (q + 1) + (xcd - r) * q) + off; }
        const int nig = WGM * nN, gid = wgid / nig, fm = gid * WGM, gsz = (nM - fm) < WGM ? (nM - fm) : WGM;
        u.pm = fm + ((wgid % nig) % gsz); u.pn = (wgid % nig) / gsz; return true;
    }
    __device__ __forceinline__ void a_ready(const Unit&) const {}
    __device__ __forceinline__ void done(const Unit&) const {}
};

__device__ __forceinline__ unsigned cvt_pk_bf16(float lo, float hi) { unsigned r; asm volatile("v_cvt_pk_bf16_f32 %0, %1, %2" : "=v"(r) : "v"(lo), "v"(hi)); return r; }
typedef float f32x2 __attribute__((ext_vector_type(2)));
__device__ __forceinline__ f32x2 gelu_pk(f32x2 v) {
    const f32x2 av = __builtin_elementwise_abs(v), d = av * 0.2316418882f + 1.0f;
    f32x2 t; t.x = __builtin_amdgcn_rcpf(d.x); t.y = __builtin_amdgcn_rcpf(d.y);
    f32x2 q = t * 0.5307027145f + (-0.7265760135f); q = q * t + 0.7107068705f; q = q * t + (-0.142248368f); q = q * t + 0.127414796f; q = q * t;
    const f32x2 s = (v * v) * (-0.72134752044f);
    f32x2 e; e.x = __builtin_amdgcn_exp2f(s.x); e.y = __builtin_amdgcn_exp2f(s.y);
    const f32x2 m = v * (q * e), r = v - m;
    f32x2 o; o.x = v.x < 0.f ? m.x : r.x; o.y = v.y < 0.f ? m.y : r.y; return o;
}

template <int ACT  > struct EpiBf16 {
    static constexpr bool PERM = true, AFTER_DRAIN = false; static_assert(ACT == 0 || ACT == 1, "EpiBf16: ACT is 0 (none) or 1 (gelu_pk)");
    bf16_t* O; int ldc; const float* bias; int split_cols; size_t split_stride; float scale0;
    __device__ __forceinline__ void operator()(const f32x4 (&acc)[2][2][4][2], const Unit& u, int wr, int wc, int fr, int fq) const {
        const int row0 = u.pm * BM + wr * 64 + fr; int colt = u.pn * BM; bf16_t* base = O;
        float sc = 1.f; if (split_cols) { const int t = colt / split_cols; base += (size_t)t * split_stride; colt -= t * split_cols; if (t == 0) sc = scale0; }
        const int col0 = colt + wc * 32 + 8 * fq, bcol0 = u.pn * BM + wc * 32 + 8 * fq;
        f32x4 bv[2][2];
#pragma unroll
        for (int bj = 0; bj < 2; ++bj)
#pragma unroll
            for (int n = 0; n < 2; ++n) bv[bj][n] = bias ? *(const f32x4*)(bias + bcol0 + bj * HALF + 4 * n) : (f32x4){0.f, 0.f, 0.f, 0.f};
#pragma unroll
        for (int ai = 0; ai < 2; ++ai)
#pragma unroll
            for (int m = 0; m < 4; ++m) { bf16_t* rowp = base + (size_t)(row0 + ai * HALF + m * 16) * ldc + col0;
#pragma unroll
                for (int bj = 0; bj < 2; ++bj) { f32x4 v0 = acc[ai][bj][m][0] + bv[bj][0], v1 = acc[ai][bj][m][1] + bv[bj][1];
                    if (ACT == 1) { f32x2 a = gelu_pk((f32x2){v0[0], v0[1]}), b = gelu_pk((f32x2){v0[2], v0[3]}), c = gelu_pk((f32x2){v1[0], v1[1]}), d = gelu_pk((f32x2){v1[2], v1[3]});
                        v0 = (f32x4){a.x, a.y, b.x, b.y}; v1 = (f32x4){c.x, c.y, d.x, d.y}; }
                    v0 = v0 * sc; v1 = v1 * sc; u32x4 w; w.x = cvt_pk_bf16(v0[0], v0[1]); w.y = cvt_pk_bf16(v0[2], v0[3]); w.z = cvt_pk_bf16(v1[0], v1[1]); w.w = cvt_pk_bf16(v1[2], v1[3]);
                    *(u32x4*)(rowp + bj * HALF) = w; } }
    }
};

struct PanelStats {
    unsigned* xbuf;
    unsigned* cnt;
    unsigned* tmo;
    int ntn; float eps;
    unsigned code;
    __device__ __forceinline__ bool run(const f32x4 (&v)[2][2][4][2], const Unit& u, int wr, int wc, int fr, int fq, PG8_LAS unsigned char* lds, int wid, int lane) const {
        typedef float f32x2v __attribute__((ext_vector_type(2)));
        PG8_LAS f32x2v* P = (PG8_LAS f32x2v*)lds;
        PG8_LAS f32x2v* S = (PG8_LAS f32x2v*)(lds + 8192);
        PG8_LAS unsigned* flag = (PG8_LAS unsigned*)(lds + 8192 + 2048);
#pragma unroll
        for (int ai = 0; ai < 2; ++ai)
#pragma unroll
            for (int m = 0; m < 4; ++m) {
                float s = 0.f;
#pragma unroll
                for (int bj = 0; bj < 2; ++bj)
#pragma unroll
                    for (int n = 0; n < 2; ++n) { const f32x4 x = v[ai][bj][m][n]; s += (x[0] + x[1]) + (x[2] + x[3]); }
                s += __shfl_xor(s, 16); s += __shfl_xor(s, 32);
                const float mw = s * (1.0f / 64.0f); float q = 0.f;
#pragma unroll
                for (int bj = 0; bj < 2; ++bj)
#pragma unroll
                    for (int n = 0; n < 2; ++n) { const f32x4 d = v[ai][bj][m][n] - mw; q += (d[0] * d[0] + d[1] * d[1]) + (d[2] * d[2] + d[3] * d[3]); }
                q += __shfl_xor(q, 16); q += __shfl_xor(q, 32);
                if (fq == 0) P[(ai * HALF + wr * 64 + m * 16 + fr) * 4 + wc] = (f32x2v){mw, q};
            }
        asm volatile("s_waitcnt lgkmcnt(0)" ::: "memory"); __builtin_amdgcn_s_barrier(); asm volatile("" ::: "memory");
#if defined(BROKEN_EXCHANGE_NO_WAIT)
#warning BROKEN CONTROL BUILD: the row-statistics exchange does not wait; results are wrong by design
        if (blockIdx.x >= 64) { const long long t0_ = clock64(); while (clock64() - t0_ < 60000) __builtin_amdgcn_s_sleep(8); }
#endif
        const int row = wid * 32 + (lane & 31);
        if (lane < 32) {
            const f32x2v a = P[row * 4 + 0], b = P[row * 4 + 1], c = P[row * 4 + 2], d = P[row * 4 + 3];
            const float mt = (a.x + b.x + c.x + d.x) * 0.25f;
            const float da = a.x - mt, db = b.x - mt, dc = c.x - mt, dd = d.x - mt;
            const float m2 = (a.y + b.y) + (c.y + d.y) + 64.0f * ((da * da + db * db) + (dc * dc + dd * dd));
            unsigned long long* slot = (unsigned long long*)xbuf + ((size_t)(u.pm * BM + row) * 4 + u.pn);
            __hip_atomic_store(slot, ((unsigned long long)__float_as_uint(m2) << 32) | __float_as_uint(mt), __ATOMIC_RELAXED, __HIP_MEMORY_SCOPE_AGENT);
        }
        asm volatile("s_waitcnt vmcnt(0)" ::: "memory");
        if (lane == 0) __hip_atomic_fetch_add(cnt + 64 * u.pm, 1u, __ATOMIC_RELAXED, __HIP_MEMORY_SCOPE_AGENT);
        if (wid == 0) {
            bool dead = false; const unsigned long long t0 = __builtin_amdgcn_s_memrealtime(); const unsigned want = 8u * (unsigned)ntn;
            for (;;) {
#if defined(BROKEN_EXCHANGE_NO_WAIT)
                break;
#endif
                if ((unsigned)__builtin_amdgcn_readfirstlane(__hip_atomic_load(cnt + 64 * u.pm, __ATOMIC_RELAXED, __HIP_MEMORY_SCOPE_AGENT)) >= want) break;
                if (__builtin_amdgcn_s_memrealtime() - t0 > 2000000ull) {
                    if (lane == 0) { unsigned expect = 0u; __hip_atomic_compare_exchange_strong(tmo + 1, &expect, code | (unsigned)(u.pm & 0xff), __ATOMIC_RELAXED, __ATOMIC_RELAXED, __HIP_MEMORY_SCOPE_AGENT);
                                     __hip_atomic_store(tmo, 1u, __ATOMIC_RELAXED, __HIP_MEMORY_SCOPE_AGENT); }
                    dead = true; break; }
                __builtin_amdgcn_s_sleep(2);
            }
            __builtin_amdgcn_fence(__ATOMIC_ACQUIRE, "agent");
            if (lane == 0) flag[0] = dead ? 1u : 0u;
        }
        asm volatile("s_waitcnt vmcnt(0) lgkmcnt(0)" ::: "memory"); __builtin_amdgcn_s_barrier(); asm volatile("" ::: "memory");
        const bool bad = flag[0] != 0u;
        if (lane < 32) {
            const unsigned long long* slot = (const unsigned long long*)xbuf + (size_t)(u.pm * BM + row) * 4; float mt[4], m2[4]; float ms = 0.f;
#pragma unroll
            for (int t = 0; t < 4; ++t) { if (t < ntn) { const unsigned long long w = __hip_atomic_load(slot + t, __ATOMIC_RELAXED, __HIP_MEMORY_SCOPE_AGENT); mt[t] = __uint_as_float((unsigned)w); m2[t] = __uint_as_float((unsigned)(w >> 32)); } else { mt[t] = 0.f; m2[t] = 0.f; } ms += mt[t]; }
            const float mean = ms / (float)ntn; float q = 0.f;
#pragma unroll
            for (int t = 0; t < 4; ++t) if (t < ntn) { const float dm = mt[t] - mean; q += m2[t] + 256.0f * dm * dm; }
            S[row] = (f32x2v){mean, 1.0f / sqrtf(q / (256.0f * (float)ntn) + eps)};
        }
        asm volatile("s_waitcnt lgkmcnt(0)" ::: "memory"); __builtin_amdgcn_s_barrier(); asm volatile("" ::: "memory");
        return bad;
    }
};
struct EpiLnRes {
    static constexpr bool PERM = false, AFTER_DRAIN = true;
    const float* base; float* out; int ldc; const float* bias; PanelStats st; unsigned poison;
    __device__ __forceinline__ void fused(f32x4 (&acc)[2][2][4][2], const Unit& u, int wr, int wc, int fr, int fq, PG8_LAS unsigned char* lds, int wid, int lane) const {
        typedef float f32x2v __attribute__((ext_vector_type(2)));
        const PG8_LAS f32x2v* S = (const PG8_LAS f32x2v*)(lds + 8192);
        const int col0 = u.pn * BM + wc * 32 + 4 * fq;
#pragma unroll
        for (int bj = 0; bj < 2; ++bj)
#pragma unroll
            for (int n = 0; n < 2; ++n) { const f32x4 bv = bias ? *(const f32x4*)(bias + col0 + bj * HALF + n * 16) : (f32x4){0.f, 0.f, 0.f, 0.f};
#pragma unroll
                for (int ai = 0; ai < 2; ++ai)
#pragma unroll
                    for (int m = 0; m < 4; ++m) acc[ai][bj][m][n] += bv; }
        f32x4 pre[4][2][2];
#pragma unroll
        for (int m = 0; m < 4; ++m) { const size_t off = (size_t)(u.pm * BM + wr * 64 + m * 16 + fr) * ldc + col0;
#pragma unroll
            for (int bj = 0; bj < 2; ++bj)
#pragma unroll
                for (int n = 0; n < 2; ++n) pre[m][bj][n] = *(const f32x4*)(base + off + bj * HALF + n * 16); }
        const bool bad = st.run(acc, u, wr, wc, fr, fq, lds, wid, lane) || poison != 0u;
        const float qnan = __builtin_nanf("");
#pragma unroll
        for (int ai = 0; ai < 2; ++ai)
#pragma unroll
            for (int m = 0; m < 4; ++m) { const int r = ai * HALF + wr * 64 + m * 16 + fr; const f32x2v sr = S[r]; const size_t off = (size_t)(u.pm * BM + r) * ldc + col0;
#pragma unroll
                for (int bj = 0; bj < 2; ++bj)
#pragma unroll
                    for (int n = 0; n < 2; ++n) { const f32x4 bs = ai == 0 ? pre[m][bj][n] : *(const f32x4*)(base + off + bj * HALF + n * 16); f32x4 o = bs + (acc[ai][bj][m][n] - sr.x) * sr.y;
                        if (bad) o = (f32x4){qnan, qnan, qnan, qnan}; *(f32x4*)(out + off + bj * HALF + n * 16) = o; }
                if (m & 1) asm volatile("" ::: "memory"); }
    }
};
struct EpiLnResLn {
    static constexpr bool PERM = false, AFTER_DRAIN = true;
    const float* base; float* out; bf16_t* xn; int ldc; const float* bias; PanelStats st1, st2; unsigned poison;
    __device__ __forceinline__ void fused(f32x4 (&acc)[2][2][4][2], const Unit& u, int wr, int wc, int fr, int fq, PG8_LAS unsigned char* lds, int wid, int lane) const {
        typedef float f32x2v __attribute__((ext_vector_type(2))); typedef unsigned u32x2v __attribute__((ext_vector_type(2)));
        const PG8_LAS f32x2v* S = (const PG8_LAS f32x2v*)(lds + 8192);
        const int col0 = u.pn * BM + wc * 32 + 4 * fq;
#pragma unroll
        for (int bj = 0; bj < 2; ++bj)
#pragma unroll
            for (int n = 0; n < 2; ++n) { const f32x4 bv = bias ? *(const f32x4*)(bias + col0 + bj * HALF + n * 16) : (f32x4){0.f, 0.f, 0.f, 0.f};
#pragma unroll
                for (int ai = 0; ai < 2; ++ai)
#pragma unroll
                    for (int m = 0; m < 4; ++m) acc[ai][bj][m][n] += bv; }
        bool bad = st1.run(acc, u, wr, wc, fr, fq, lds, wid, lane) || poison != 0u;
        const float qnan = __builtin_nanf("");
#pragma unroll
        for (int ai = 0; ai < 2; ++ai)
#pragma unroll
            for (int m = 0; m < 4; ++m) { const int r = ai * HALF + wr * 64 + m * 16 + fr; const f32x2v sr = S[r]; const size_t off = (size_t)(u.pm * BM + r) * ldc + col0;
#pragma unroll
                for (int bj = 0; bj < 2; ++bj)
#pragma unroll
                    for (int n = 0; n < 2; ++n) { const f32x4 bs = *(const f32x4*)(base + off + bj * HALF + n * 16); acc[ai][bj][m][n] = bs + (acc[ai][bj][m][n] - sr.x) * sr.y; }
                asm volatile("" : "+v"(acc[ai][0][m][0]), "+v"(acc[ai][0][m][1]), "+v"(acc[ai][1][m][0]), "+v"(acc[ai][1][m][1]));
                if (m & 1) asm volatile("" ::: "memory"); }
        const bool bad1 = bad;
        bad = st2.run(acc, u, wr, wc, fr, fq, lds, wid, lane) || bad;
#pragma unroll
        for (int ai = 0; ai < 2; ++ai)
#pragma unroll
            for (int m = 0; m < 4; ++m) { const int r = ai * HALF + wr * 64 + m * 16 + fr; const f32x2v sr = S[r]; const size_t off = (size_t)(u.pm * BM + r) * ldc + col0;
#pragma unroll
                for (int bj = 0; bj < 2; ++bj)
#pragma unroll
                    for (int n = 0; n < 2; ++n) { const f32x4 x1 = acc[ai][bj][m][n]; *(f32x4*)(out + off + bj * HALF + n * 16) = bad1 ? (f32x4){qnan, qnan, qnan, qnan} : x1;
                        const f32x4 o = (x1 - sr.x) * sr.y; u32x2v w; w.x = cvt_pk_bf16(o[0], o[1]); w.y = cvt_pk_bf16(o[2], o[3]);
                        if (bad) { w.x = 0x7fc07fc0u; w.y = 0x7fc07fc0u; } *(u32x2v*)(xn + off + bj * HALF + n * 16) = w; }
                asm volatile("" ::: "memory"); }
    }
};

template <class Epi, class Sched, bool ALIGN_EPI = false, bool SP2 = false>
__device__ __forceinline__ void gemm_phase(PG8_LAS unsigned char* lds, const Gemm g, const Sched& S, const Epi& E) {
    int tid_l = threadIdx.x; asm volatile("" : "+v"(tid_l));
    const int tid = tid_l, wid = __builtin_amdgcn_readfirstlane(tid >> 6), lane = tid & 63, wr = wid >> 2, wc = wid & 3, fr = lane & 15, fq = lane >> 4;
    const int K = g.K, nt = K / BK;
    unsigned voffA[2], voffB[2];
#pragma unroll
    for (int i = 0; i < 2; ++i) { int R, C; stage_rc(tid * 16 + i * 8192, R, C); const int Rb = Epi::PERM ? ((R & ~31) + perm32(R & 31)) : R;
        voffA[i] = (unsigned)(R * K + C) * 2u; voffB[i] = (unsigned)(Rb * K + C) * 2u; }
    const size_t kstep = (size_t)(BK * 2);
    const size_t hstep = (size_t)HALF * K * 2;
    const size_t tstep = 2 * hstep;
    const unsigned ldsw = (unsigned)wid * 1024u;
    const int aoff = lds_byte(wr * 64 + fr, fq * 8), boff = lds_byte(wc * 32 + fr, fq * 8);
#define PG8_SA(b, h) (((b) * 2 + (h)) * HTB)
#define PG8_SB(b, h) ((4 + (b) * 2 + (h)) * HTB)
#define PG8_STAGE(bufoff, gbase, voff) do { _Pragma("unroll") for (int _i = 0; _i < 2; ++_i) \
        __builtin_amdgcn_global_load_lds((const unsigned*)((const char*)(gbase) + (voff)[_i]), (PG8_LAS unsigned*)(lds + (bufoff) + ldsw + _i * 8192), 16, 0, 0); } while (0)
#define PG8_LDA(dst, b, h) do { _Pragma("unroll") for (int m = 0; m < 4; ++m) _Pragma("unroll") for (int k = 0; k < 2; ++k) dst[m][k] = *(const PG8_LAS bf16x8*)(lds + PG8_SA(b, h) + aoff + m * 2048 + k * 1024); } while (0)
#define PG8_LDB(dst, b, h) do { _Pragma("unroll") for (int n = 0; n < 2; ++n) _Pragma("unroll") for (int k = 0; k < 2; ++k) dst[n][k] = *(const PG8_LAS bf16x8*)(lds + PG8_SB(b, h) + boff + n * 2048 + k * 1024); } while (0)
#define PG8_MMA(ai, bj, At, Bt) do { __builtin_amdgcn_s_setprio(1); _Pragma("unroll") for (int m = 0; m < 4; ++m) _Pragma("unroll") for (int n = 0; n < 2; ++n) _Pragma("unroll") for (int k = 0; k < 2; ++k) \
        acc[ai][bj][m][n] = __builtin_amdgcn_mfma_f32_16x16x32_bf16(Bt[n][k], At[m][k], acc[ai][bj][m][n], 0, 0, 0); __builtin_amdgcn_s_setprio(0); } while (0)
#define PG8_WAIT_V(n) asm volatile("s_waitcnt vmcnt(" #n ")" ::: "memory")
#define PG8_WAIT_L(n) asm volatile("s_waitcnt lgkmcnt(" #n ")" ::: "memory")
#define PG8_BAR __builtin_amdgcn_s_barrier()
#define PG8_SCHED __builtin_amdgcn_sched_barrier(0)
    Unit cur, nxt; int ui = 0;
    if (!S.next(0, cur)) return;
    f32x4 acc[2][2][4][2];
#pragma unroll
    for (int a = 0; a < 2; ++a)
#pragma unroll
        for (int b = 0; b < 2; ++b)
#pragma unroll
            for (int m = 0; m < 4; ++m)
#pragma unroll
                for (int n = 0; n < 2; ++n) acc[a][b][m][n] = (f32x4){0.f, 0.f, 0.f, 0.f};
    bf16x8 At[4][2], B0[2][2], B1[2][2];
    const char* cA = (const char*)g.A + (size_t)cur.pm * tstep; const char* cB = (const char*)g.Bt + (size_t)cur.pn * tstep;
    S.a_ready(cur);
    if constexpr (SP2) {
        PG8_STAGE(PG8_SB(0, 0), cB, voffB); PG8_STAGE(PG8_SB(0, 1), cB + hstep, voffB); PG8_STAGE(PG8_SA(0, 0), cA, voffA); PG8_STAGE(PG8_SA(0, 1), cA + hstep, voffA);
        if (wr == 1) PG8_BAR;
        PG8_WAIT_V(2); PG8_BAR;
        PG8_STAGE(PG8_SB(1, 0), cB + kstep, voffB); PG8_STAGE(PG8_SA(1, 0), cA + kstep, voffA); PG8_STAGE(PG8_SB(1, 1), cB + hstep + kstep, voffB);
        PG8_WAIT_V(6); PG8_BAR;
    } else {
        PG8_STAGE(PG8_SB(0, 0), cB, voffB); PG8_STAGE(PG8_SA(0, 0), cA, voffA); PG8_STAGE(PG8_SB(0, 1), cB + hstep, voffB); PG8_STAGE(PG8_SA(0, 1), cA + hstep, voffA);
        if (wr == 1) PG8_BAR;
        PG8_WAIT_V(4); PG8_BAR;
        PG8_STAGE(PG8_SB(1, 0), cB + kstep, voffB); PG8_STAGE(PG8_SA(1, 0), cA + kstep, voffA); PG8_STAGE(PG8_SB(1, 1), cB + hstep + kstep, voffB);
        PG8_WAIT_V(6); PG8_BAR;
    }
    for (;;) {
        const bool has_next = S.next(ui + 1, nxt);
        const char* nA = has_next ? (const char*)g.A + (size_t)nxt.pm * tstep : cA; const char* nB = has_next ? (const char*)g.Bt + (size_t)nxt.pn * tstep : cB;
        for (int t = 0; t < nt; t += 2) {
            const bool last = (t == nt - 2);
            const char* a1 = cA + (size_t)(t + 1) * kstep;
            const char* a2 = last ? nA : cA + (size_t)(t + 2) * kstep; const char* b2 = last ? nB : cB + (size_t)(t + 2) * kstep;
            const char* a3 = a2 + kstep; const char* b3 = b2 + kstep;
            if (last && has_next) S.a_ready(nxt);
            if constexpr (SP2) {
            PG8_LDB(B0, 0, 0); PG8_LDB(B1, 0, 1); PG8_SCHED; PG8_LDA(At, 0, 0); PG8_STAGE(PG8_SA(1, 1), a1 + hstep, voffA);
            PG8_WAIT_V(8); PG8_WAIT_L(0); PG8_BAR; PG8_MMA(0, 0, At, B0); PG8_MMA(0, 1, At, B1); PG8_BAR; PG8_SCHED;
            PG8_LDA(At, 0, 1); PG8_STAGE(PG8_SB(0, 0), b2, voffB); PG8_STAGE(PG8_SB(0, 1), b2 + hstep, voffB); PG8_STAGE(PG8_SA(0, 0), a2, voffA);
            PG8_WAIT_V(8); PG8_WAIT_L(0); PG8_BAR; PG8_MMA(1, 0, At, B0); PG8_MMA(1, 1, At, B1); PG8_BAR; PG8_SCHED;
            PG8_LDB(B0, 1, 0); PG8_LDB(B1, 1, 1); PG8_SCHED; PG8_LDA(At, 1, 0); PG8_STAGE(PG8_SA(0, 1), a2 + hstep, voffA);
            PG8_WAIT_V(8); PG8_WAIT_L(0); PG8_BAR; PG8_MMA(0, 0, At, B0); PG8_MMA(0, 1, At, B1); PG8_BAR; PG8_SCHED;
            PG8_LDA(At, 1, 1); PG8_STAGE(PG8_SB(1, 0), b3, voffB); PG8_STAGE(PG8_SB(1, 1), b3 + hstep, voffB); PG8_STAGE(PG8_SA(1, 0), a3, voffA);
            PG8_WAIT_V(8); PG8_WAIT_L(0); PG8_BAR; PG8_MMA(1, 0, At, B0); PG8_MMA(1, 1, At, B1); PG8_BAR; PG8_SCHED;
            } else {
            PG8_LDB(B0, 0, 0); PG8_SCHED; PG8_LDA(At, 0, 0); PG8_STAGE(PG8_SA(1, 1), a1 + hstep, voffA);
            PG8_WAIT_L(8); PG8_BAR; PG8_WAIT_L(0); PG8_MMA(0, 0, At, B0); PG8_BAR; PG8_SCHED;
            PG8_LDB(B1, 0, 1); PG8_STAGE(PG8_SB(0, 0), b2, voffB);
            PG8_BAR; PG8_WAIT_L(0); PG8_MMA(0, 1, At, B1); PG8_BAR;
            PG8_LDA(At, 0, 1); PG8_STAGE(PG8_SA(0, 0), a2, voffA);
            PG8_BAR; PG8_WAIT_L(0); PG8_MMA(1, 0, At, B0); PG8_BAR; PG8_SCHED;
            PG8_STAGE(PG8_SB(0, 1), b2 + hstep, voffB);
            PG8_WAIT_V(6); PG8_BAR; PG8_MMA(1, 1, At, B1); PG8_BAR;
            PG8_LDB(B0, 1, 0); PG8_SCHED; PG8_LDA(At, 1, 0); PG8_STAGE(PG8_SA(0, 1), a2 + hstep, voffA);
            PG8_WAIT_L(8); PG8_BAR; PG8_WAIT_L(0); PG8_MMA(0, 0, At, B0); PG8_BAR; PG8_SCHED;
            PG8_LDB(B1, 1, 1); PG8_STAGE(PG8_SB(1, 0), b3, voffB);
            PG8_BAR; PG8_WAIT_L(0); PG8_MMA(0, 1, At, B1); PG8_BAR;
            PG8_LDA(At, 1, 1); PG8_STAGE(PG8_SA(1, 0), a3, voffA);
            PG8_BAR; PG8_WAIT_L(0); PG8_MMA(1, 0, At, B0); PG8_BAR; PG8_SCHED;
            PG8_STAGE(PG8_SB(1, 1), b3 + hstep, voffB);
            PG8_WAIT_V(6); PG8_BAR; PG8_MMA(1, 1, At, B1); PG8_BAR;
            }
        }
        if constexpr (ALIGN_EPI) { if (wr == 0) PG8_BAR; }
        if constexpr (!Epi::AFTER_DRAIN) { E(acc, cur, wr, wc, fr, fq); S.done(cur); }
        if (!has_next) break;
#pragma unroll
        for (int a = 0; a < 2; ++a)
#pragma unroll
            for (int b = 0; b < 2; ++b)
#pragma unroll
                for (int m = 0; m < 4; ++m)
#pragma unroll
                    for (int n = 0; n < 2; ++n) acc[a][b][m][n] = (f32x4){0.f, 0.f, 0.f, 0.f};
        cur = nxt; cA = nA; cB = nB; ++ui;
        if constexpr (ALIGN_EPI) { if (wr == 1) PG8_BAR; }
    }
    PG8_WAIT_V(0);
    if constexpr (!ALIGN_EPI) { if (wr == 0) PG8_BAR; }
    PG8_BAR;
    if constexpr (Epi::AFTER_DRAIN) { E.fused(acc, cur, wr, wc, fr, fq, lds, wid, lane); S.done(cur); }
#undef PG8_SA
#undef PG8_SB
#undef PG8_STAGE
#undef PG8_LDA
#undef PG8_LDB
#undef PG8_MMA
#undef PG8_WAIT_V
#undef PG8_WAIT_L
#undef PG8_BAR
#undef PG8_SCHED
}
}
typedef unsigned short bf16_t;
#define LAS __attribute__((address_space(3)))
typedef float f32x4 __attribute__((ext_vector_type(4)));
typedef float f32x2 __attribute__((ext_vector_type(2)));
typedef float f32x16 __attribute__((ext_vector_type(16)));
typedef short bf16x8 __attribute__((ext_vector_type(8)));
typedef unsigned u32x4 __attribute__((ext_vector_type(4)));
typedef unsigned u32x2 __attribute__((ext_vector_type(2)));

constexpr int M = 16384, SEQ = 4096, D = 1024, DFF = 2816, NGU = 5632, DIN = 3344, DINP = 3584, DEPTH = 4;
constexpr float ALPHA = 1.681792830507429f;
constexpr float LN_EPS = 1e-5f;
constexpr int C_DQ = 0, C_DK = 256, C_DV = 512, C_MZ = 768, C_MXBC = 1280, C_MDT = 2304, C_GQ = 2312, C_GZ = 3080, C_GB = 3336, C_GA = 3340;

constexpr size_t MiB = 1u << 20;
constexpr size_t WS_ROPE = 1 * MiB;
constexpr size_t WS_WGU1 = 2 * MiB, WS_WD1 = 13 * MiB, WS_WGU2 = 19 * MiB, WS_WD2 = 30 * MiB, WS_WIN = 36 * MiB, WS_WOUT = 43 * MiB;
constexpr size_t WS_XN = 46 * MiB;
constexpr size_t WS_HB = 78 * MiB;
constexpr size_t WS_XC = 190 * MiB;
constexpr size_t WS_BC = 206 * MiB;
constexpr size_t WS_DTX = 238 * MiB;
constexpr size_t WS_GQK = 270 * MiB;
constexpr size_t WS_GV = 302 * MiB;
constexpr size_t WS_SC = 310 * MiB;
constexpr size_t WS_YM = 312 * MiB;
constexpr size_t WS_OD = 344 * MiB;
constexpr size_t WS_MIX = 360 * MiB;
constexpr size_t WS_END = 392 * MiB;

constexpr int LDS_BYTES = 147456;
constexpr int NWAVES = 8;

__device__ __forceinline__ float bf2f(unsigned u) { return __uint_as_float(u << 16); }
__device__ __forceinline__ unsigned f2bf(float f) { unsigned u = __float_as_uint(f); return (u + 0x7fffu + ((u >> 16) & 1u)) >> 16; }
__device__ __forceinline__ unsigned pk2(float lo, float hi) { return f2bf(lo) | (f2bf(hi) << 16); }
__device__ __forceinline__ float silu_f(float x) { return x / (1.f + __expf(-x)); }
__device__ __forceinline__ float softplus_f(float x) { return fmaxf(x, 0.f) + log1pf(__expf(-fabsf(x))); }
__device__ __forceinline__ float sigmoid_f(float x) { return 1.f / (1.f + __expf(-x)); }

template <int CTRL> __device__ __forceinline__ float dpp_mov(float v) {
    return __builtin_bit_cast(float, __builtin_amdgcn_update_dpp(0, __builtin_bit_cast(int, v), CTRL, 0xF, 0xF, true));
}
__device__ __forceinline__ float wave_sum(float v) {
    v += dpp_mov<0xB1>(v);
    v += dpp_mov<0x4E>(v);
    v += dpp_mov<0x141>(v);
    v += dpp_mov<0x140>(v);
    { auto rr = __builtin_amdgcn_permlane16_swap(__float_as_uint(v), __float_as_uint(v), false, false); v = __uint_as_float(rr[0]) + __uint_as_float(rr[1]); }
    { auto rr = __builtin_amdgcn_permlane32_swap(__float_as_uint(v), __float_as_uint(v), false, false); v = __uint_as_float(rr[0]) + __uint_as_float(rr[1]); }
    return v;
}
__device__ __forceinline__ float xor32(float v) { auto rr = __builtin_amdgcn_permlane32_swap(__float_as_uint(v), __float_as_uint(v), false, false); return (threadIdx.x & 32) ? __uint_as_float(rr[0]) : __uint_as_float(rr[1]); }

namespace pg8 {
struct EpiSwiglu {
    static constexpr bool PERM = true, AFTER_DRAIN = false;
    bf16_t* O;
    __device__ __forceinline__ void operator()(const f32x4 (&acc)[2][2][4][2], const Unit& u, int wr, int wc, int fr, int fq) const {
        const int row0 = u.pm * BM + wr * 64 + fr; const int hid0 = u.pn * 128 + wc * 16 + 4 * fq;
#pragma unroll
        for (int ai = 0; ai < 2; ++ai)
#pragma unroll
            for (int m = 0; m < 4; ++m) { bf16_t* rowp = O + (size_t)(row0 + ai * HALF + m * 16) * 2816 + hid0;
#pragma unroll
                for (int bj = 0; bj < 2; ++bj) { const f32x4 g = acc[ai][bj][m][0], up = acc[ai][bj][m][1]; float v[4];
#pragma unroll
                    for (int j = 0; j < 4; ++j) v[j] = g[j] / (1.f + __expf(-g[j])) * up[j];
                    typedef unsigned u32x2v __attribute__((ext_vector_type(2))); u32x2v w; w.x = cvt_pk_bf16(v[0], v[1]); w.y = cvt_pk_bf16(v[2], v[3]);
                    *(u32x2v*)(rowp + bj * 64) = w; } }
    }
};
struct EpiResid {
    static constexpr bool PERM = false, AFTER_DRAIN = false;
    float* X; float alpha, s;
    __device__ __forceinline__ void operator()(const f32x4 (&acc)[2][2][4][2], const Unit& u, int wr, int wc, int fr, int fq) const {
        const int col0 = u.pn * BM + wc * 32 + 4 * fq;
#pragma unroll
        for (int ai = 0; ai < 2; ++ai)
#pragma unroll
            for (int m = 0; m < 4; ++m) { float* rowp = X + (size_t)(u.pm * BM + ai * HALF + wr * 64 + m * 16 + fr) * 1024 + col0;
#pragma unroll
                for (int bj = 0; bj < 2; ++bj)
#pragma unroll
                    for (int n = 0; n < 2; ++n) { f32x4* p = (f32x4*)(rowp + bj * HALF + n * 16); const f32x4 x = *p; *p = x * alpha + acc[ai][bj][m][n] * s; }
                asm volatile("" ::: "memory"); }
    }
};
struct EpiInproj {
    static constexpr bool PERM = true, AFTER_DRAIN = false;
    bf16_t* O; const float* rope;
    __device__ __forceinline__ void operator()(const f32x4 (&acc)[2][2][4][2], const Unit& u, int wr, int wc, int fr, int fq) const {
        const int row0 = u.pm * BM + wr * 64 + fr; const int col0 = u.pn * BM + wc * 32 + 8 * fq;
        const bool rot = (u.pn < 2) && (fq == 0);
#pragma unroll
        for (int ai = 0; ai < 2; ++ai)
#pragma unroll
            for (int m = 0; m < 4; ++m) { const int row = row0 + ai * HALF + m * 16; bf16_t* rowp = O + (size_t)row * 3584 + col0;
                f32x4 cs0 = {1.f, 0.f, 1.f, 0.f}, cs1 = {1.f, 0.f, 1.f, 0.f};
                if (rot) { const f32x4* rp = (const f32x4*)(rope + (size_t)(row & 4095) * 8); cs0 = rp[0]; cs1 = rp[1]; }
#pragma unroll
                for (int bj = 0; bj < 2; ++bj) { f32x4 v0 = acc[ai][bj][m][0], v1 = acc[ai][bj][m][1];
                    if (rot) { const float c[4] = {cs0[0], cs0[2], cs1[0], cs1[2]}, s[4] = {cs0[1], cs0[3], cs1[1], cs1[3]}; f32x4 a, b;
#pragma unroll
                        for (int j = 0; j < 4; ++j) { a[j] = v0[j] * c[j] - v1[j] * s[j]; b[j] = v1[j] * c[j] + v0[j] * s[j]; }
                        v0 = a; v1 = b; }
                    u32x4 w; w.x = cvt_pk_bf16(v0[0], v0[1]); w.y = cvt_pk_bf16(v0[2], v0[3]); w.z = cvt_pk_bf16(v1[0], v1[1]); w.w = cvt_pk_bf16(v1[2], v1[3]);
                    *(u32x4*)(rowp + bj * HALF) = w; } }
    }
};
}
#define XB_TMO      128
#define XB_XCNT(j)  (256  + 64 * (j))
#define XB_XSUB(j)  (1280 + 64 * (j))
#define XB_XGEN(j)  (2304 + 64 * (j))
#define XB_TOP      3328
#define XB_TOPGEN   3392
#define XCD_BAR_WORDS 3456
#define XB_SPIN_CAP (1u << 18)

__device__ __forceinline__ unsigned xb_ld(unsigned* p)              { return __hip_atomic_load(p, __ATOMIC_RELAXED, __HIP_MEMORY_SCOPE_AGENT); }
__device__ __forceinline__ unsigned xb_add(unsigned* p, unsigned v) { return __hip_atomic_fetch_add(p, v, __ATOMIC_RELAXED, __HIP_MEMORY_SCOPE_AGENT); }
__device__ __forceinline__ unsigned xb_xcc_id() { return (unsigned)__builtin_amdgcn_s_getreg((3 << 11) | 20) & 0xFu; }
#define XB_SPIN(cond, bar) do { unsigned _sp = 0; while (cond) { __builtin_amdgcn_s_sleep(1); \
    if ((++_sp & 255u) == 0u) { if (xb_ld(&(bar)[XB_TMO])) break; if (_sp > XB_SPIN_CAP) { atomicAdd(&(bar)[XB_TMO], 1u); break; } } } } while (0)

struct XcdBarrier {
    unsigned* bar; unsigned x;
    volatile LAS unsigned* st;
};

__device__ __forceinline__ XcdBarrier xcd_barrier_post(unsigned* bar, volatile LAS unsigned* st) {
    XcdBarrier b; b.bar = bar; b.x = xb_xcc_id(); b.st = st;
    if (threadIdx.x == 0) (void)xb_add(&bar[XB_XCNT(b.x)], 1u);
    return b;
}
__device__ __forceinline__ void xcd_barrier_complete(unsigned* bar, unsigned x, unsigned& nloc, unsigned& nx) {
    const unsigned G = gridDim.x * gridDim.y * gridDim.z;
    unsigned sum, cnt, mine, sp = 0u;
    for (;;) {
        sum = 0u; cnt = 0u; mine = 0u;
#pragma unroll
        for (unsigned j = 0; j < 16; ++j) { const unsigned c = xb_ld(&bar[XB_XCNT(j)]); sum += c; cnt += (c > 0u) ? 1u : 0u; mine = (j == x) ? c : mine; }
        if (sum == G) break;
        __builtin_amdgcn_s_sleep(1);
        if ((++sp & 255u) == 0u) { if (xb_ld(&bar[XB_TMO])) break; if (sp > XB_SPIN_CAP) { atomicAdd(&bar[XB_TMO], 1u); break; } }
    }
    nloc = mine > 0u ? mine : 1u; nx = cnt > 0u ? cnt : 1u;
}

__device__ __forceinline__ void xcd_barrier(const XcdBarrier& b) {
    asm volatile("s_waitcnt vmcnt(0)" ::: "memory");
    __syncthreads();
    if (threadIdx.x == 0) {
        unsigned* bar = b.bar;
        __builtin_amdgcn_s_waitcnt(0);
        unsigned nloc = b.st[0], nx = b.st[1];
        if (nloc == 0u) { xcd_barrier_complete(bar, b.x, nloc, nx); b.st[0] = nloc; b.st[1] = nx; }
        const unsigned old = xb_add(&bar[XB_XSUB(b.x)], 1u);
        const unsigned gen = old / nloc;
        if (old + 1u == (gen + 1u) * nloc) {
            __builtin_amdgcn_fence(__ATOMIC_RELEASE, "agent");
            asm volatile("s_waitcnt vmcnt(0)" ::: "memory");
            const unsigned og = xb_add(&bar[XB_TOP], 1u);
            const unsigned tg = og / nx;
            if (og + 1u == (tg + 1u) * nx) xb_add(&bar[XB_TOPGEN], 1u);
            else XB_SPIN(xb_ld(&bar[XB_TOPGEN]) == tg, bar);
            __builtin_amdgcn_fence(__ATOMIC_ACQUIRE, "agent");
            xb_add(&bar[XB_XGEN(b.x)], 1u);
            asm volatile("s_waitcnt vmcnt(0)" ::: "memory");
        } else {
            XB_SPIN(xb_ld(&bar[XB_XGEN(b.x)]) == gen, bar);
            __builtin_amdgcn_fence(__ATOMIC_ACQUIRE, "agent");
            asm volatile("s_waitcnt vmcnt(0)" ::: "memory");
        }
    }
    __syncthreads();
}
struct Args { const float* in[25]; float* out; unsigned char* ws; };

template <int MODE>
__device__ __forceinline__ void transpose_item(const float* W, int K, int N, bf16_t* WT, LAS float* scr, int item, int lane) {
    const int nblk = (N + 31) / 32, kb = item / nblk, nb = item % nblk, k0 = 64 * kb, n0 = 32 * nb;
    const int col = n0 + (lane & 31);
#pragma unroll 8
    for (int i = 0; i < 32; ++i) { const int kk = 2 * i + (lane >> 5); scr[kk * 33 + (lane & 31)] = (col < N) ? W[(size_t)(k0 + kk) * N + col] : 0.f; }
    asm volatile("s_waitcnt lgkmcnt(0)" ::: "memory");
    const int c = lane & 7;
#pragma unroll
    for (int j = 0; j < 4; ++j) { const int n = (lane >> 3) + 8 * j; const LAS float* s = scr + (8 * c) * 33 + n;
        u32x4 o; o.x = pk2(s[0 * 33], s[1 * 33]); o.y = pk2(s[2 * 33], s[3 * 33]); o.z = pk2(s[4 * 33], s[5 * 33]); o.w = pk2(s[6 * 33], s[7 * 33]);
        int src = n0 + n, dst = src;
        if (MODE == 1) { const int nf = src >= DFF ? 1 : 0; const int uu = src - nf * DFF; dst = (uu >> 2) * 8 + nf * 4 + (uu & 3); }
        *(u32x4*)(WT + (size_t)dst * K + k0 + 8 * c) = o; }
    asm volatile("s_waitcnt lgkmcnt(0)" ::: "memory");
}
__device__ __forceinline__ void convert_layer(const Args& a, int l, LAS unsigned char* lds) {
    int tid_l = threadIdx.x; asm volatile("" : "+v"(tid_l)); const int tid = tid_l, lane = tid & 63, wave = __builtin_amdgcn_readfirstlane(tid >> 6); const int gw = blockIdx.x * NWAVES + wave, NGW = gridDim.x * NWAVES; (void)gw; (void)NGW; (void)lane; (void)wave;
    LAS float* scr = (LAS float*)(lds + wave * 16384);
    unsigned char* ws = a.ws;
    constexpr int I_GU = (D / 64) * (NGU / 32), I_D = (DFF / 64) * (D / 32), I_IN = (D / 64) * ((DIN + 31) / 32), I_OUT = (D / 64) * (D / 32);
    constexpr int NIT = 2 * I_GU + 2 * I_D + I_IN + I_OUT;
    for (int it = gw; it < NIT; it += NGW) {
        int r = it;
        if (r < I_GU) { transpose_item<1>(a.in[1] + (size_t)l * D * NGU, D, NGU, (bf16_t*)(ws + WS_WGU1), scr, r, lane); continue; } r -= I_GU;
        if (r < I_GU) { transpose_item<1>(a.in[21] + (size_t)l * D * NGU, D, NGU, (bf16_t*)(ws + WS_WGU2), scr, r, lane); continue; } r -= I_GU;
        if (r < I_D) { transpose_item<0>(a.in[2] + (size_t)l * DFF * D, DFF, D, (bf16_t*)(ws + WS_WD1), scr, r, lane); continue; } r -= I_D;
        if (r < I_D) { transpose_item<0>(a.in[22] + (size_t)l * DFF * D, DFF, D, (bf16_t*)(ws + WS_WD2), scr, r, lane); continue; } r -= I_D;
        if (r < I_IN) { transpose_item<0>(a.in[5] + (size_t)l * D * DIN, D, DIN, (bf16_t*)(ws + WS_WIN), scr, r, lane); continue; } r -= I_IN;
        transpose_item<0>(a.in[18] + (size_t)l * D * D, D, D, (bf16_t*)(ws + WS_WOUT), scr, r, lane);
    }
}

__device__ __forceinline__ void ln_rows(float* X, const float* g, const float* b, bf16_t* XN) {
    int tid_l = threadIdx.x; asm volatile("" : "+v"(tid_l)); const int tid = tid_l, lane = tid & 63, wave = __builtin_amdgcn_readfirstlane(tid >> 6); const int gw = blockIdx.x * NWAVES + wave, NGW = gridDim.x * NWAVES; (void)gw; (void)NGW; (void)lane; (void)wave;
    f32x4 gv[4], bv[4];
#pragma unroll
    for (int j = 0; j < 4; ++j) { gv[j] = ((const f32x4*)g)[lane + 64 * j]; bv[j] = ((const f32x4*)b)[lane + 64 * j]; }
    for (int m = gw; m < M; m += NGW) {
        f32x4* xr = (f32x4*)(X + (size_t)m * D) + lane;
        f32x4 v[4]; float s = 0.f;
#pragma unroll
        for (int j = 0; j < 4; ++j) { v[j] = xr[64 * j]; s += (v[j].x + v[j].y) + (v[j].z + v[j].w); }
        const float mean = wave_sum(s) * (1.f / D); float s2 = 0.f;
#pragma unroll
        for (int j = 0; j < 4; ++j) { v[j] = v[j] - mean; s2 += (v[j].x * v[j].x + v[j].y * v[j].y) + (v[j].z * v[j].z + v[j].w * v[j].w); }
        const float rstd = rsqrtf(wave_sum(s2) * (1.f / D) + LN_EPS);
        u32x2* o8 = (u32x2*)(XN + (size_t)m * D) + lane;
#pragma unroll
        for (int j = 0; j < 4; ++j) { const f32x4 y = v[j] * rstd * gv[j] + bv[j]; xr[64 * j] = y; u32x2 w; w.x = pk2(y.x, y.y); w.y = pk2(y.z, y.w); o8[64 * j] = w; }
    }
}

__device__ __forceinline__ void prologue(const Args& a) {
    int tid_l = threadIdx.x; asm volatile("" : "+v"(tid_l)); const int tid = tid_l, lane = tid & 63, wave = __builtin_amdgcn_readfirstlane(tid >> 6); const int gw = blockIdx.x * NWAVES + wave, NGW = gridDim.x * NWAVES; (void)gw; (void)NGW; (void)lane; (void)wave;
    float* rope = (float*)(a.ws + WS_ROPE);
    const int gt = gw * 64 + lane;
    if (gt < 4096 * 4) {
        const int pos = gt >> 2, i = gt & 3;
        const float invf = (i == 0) ? 1.0f : (i == 1) ? 0.03760603070259094f : (i == 2) ? 0.0014142135623842478f : 5.3182957344688475e-05f;
        const float ang = (float)pos * invf;
        const double x = (double)ang; const double k = rint(x * 0.15915494309189535); const double r = x - k * 6.283185307179586;
        const double r2 = r * r; double sn = 1.0, cs = 1.0, ts = 1.0, tc = 1.0;
#pragma unroll
        for (int n = 1; n <= 12; ++n) { tc *= -r2 / (double)((2 * n - 1) * (2 * n)); ts *= -r2 / (double)((2 * n) * (2 * n + 1)); cs += tc; sn += ts; }
        sn *= r;
        rope[gt * 2] = (float)cs; rope[gt * 2 + 1] = (float)sn;
    }
    const float* x = a.in[0]; float* X = a.out; bf16_t* XN = (bf16_t*)(a.ws + WS_XN);
    for (int m = gw; m < M; m += NGW) {
        const f32x4* xr = (const f32x4*)(x + (size_t)m * D) + lane; f32x4* o = (f32x4*)(X + (size_t)m * D) + lane; u32x2* o8 = (u32x2*)(XN + (size_t)m * D) + lane;
#pragma unroll
        for (int j = 0; j < 4; ++j) { const f32x4 v = xr[64 * j]; o[64 * j] = v; u32x2 w; w.x = pk2(v.x, v.y); w.y = pk2(v.z, v.w); o8[64 * j] = w; }
    }
}

constexpr int PREP_SDT = 131072 + 1024, PREP_SBETA = PREP_SDT + 2048;
__device__ __forceinline__ void prep_phase(const Args& a, int l, LAS unsigned char* lds) {
    int tid_l = threadIdx.x; asm volatile("" : "+v"(tid_l)); const int tid = tid_l, lane = tid & 63, wave = __builtin_amdgcn_readfirstlane(tid >> 6);
    const bf16_t* Hb = (const bf16_t*)(a.ws + WS_HB); bf16_t* XC = (bf16_t*)(a.ws + WS_XC); float* BC = (float*)(a.ws + WS_BC); float* DTX = (float*)(a.ws + WS_DTX);
    float* GQK = (float*)(a.ws + WS_GQK); bf16_t* GV = (bf16_t*)(a.ws + WS_GV); float* SC = (float*)(a.ws + WS_SC);
    const float* mcw = a.in[8] + (size_t)l * 4 * 1024; const float* mcb = a.in[9] + (size_t)l * 1024;
    const float* mdtb = a.in[10] + l * 8; const float* mAl = a.in[11] + l * 8;
    const float* gcw = a.in[14] + (size_t)l * 4 * 768; const float* gAl = a.in[15] + l * 4; const float* gdtb = a.in[16] + l * 4;
    LAS float* qk = (LAS float*)lds;
    LAS float* sdt = (LAS float*)(lds + PREP_SDT);
    LAS float* sbeta = (LAS float*)(lds + PREP_SBETA);
    for (int blk = blockIdx.x; blk < M / 64; blk += gridDim.x) {
        const int row0 = blk * 64; const bool has_halo = (row0 & (SEQ - 1)) != 0;
        for (int it = tid; it < 64 * 16; it += 512) {
            const int r = it >> 4, j = it & 15; const size_t row = row0 + r; const bf16_t* hr = Hb + row * DINP; float* sc = SC + row * 32;
            if (j < 8) { const float dt = softplus_f(bf2f(hr[C_MDT + j]) + mdtb[j]); sc[j] = dt; sc[8 + j] = __expf(-dt * __expf(mAl[j])); sdt[r * 8 + j] = dt; }
            else if (j < 12) { const int hh = j - 8; const float beta = sigmoid_f(bf2f(hr[C_GB + hh])); const float g = -__expf(gAl[hh]) * softplus_f(bf2f(hr[C_GA + hh]) + gdtb[hh]); const float dec = __expf(g);
                sc[16 + 2 * hh] = beta * dec; sc[17 + 2 * hh] = dec; sbeta[r * 4 + hh] = beta; }
        }
        __syncthreads();
        {
            const int ch = 2 * tid; const int col = C_MXBC + ch;
            float w[4][2], bias[2];
#pragma unroll
            for (int k = 0; k < 4; ++k) { w[k][0] = mcw[k * 1024 + ch]; w[k][1] = mcw[k * 1024 + ch + 1]; }
            bias[0] = mcb[ch]; bias[1] = mcb[ch + 1];
            float xm[3][2];
#pragma unroll
            for (int k = 0; k < 3; ++k) { unsigned u = 0; if (has_halo) u = *(const unsigned*)(Hb + (size_t)(row0 - 3 + k) * DINP + col); xm[k][0] = bf2f(u & 0xffffu); xm[k][1] = bf2f(u >> 16); }
#pragma unroll 4
            for (int r = 0; r < 64; ++r) {
                const unsigned u = *(const unsigned*)(Hb + (size_t)(row0 + r) * DINP + col); const float x0 = bf2f(u & 0xffffu), x1 = bf2f(u >> 16);
                const float a0 = silu_f(w[0][0] * xm[0][0] + w[1][0] * xm[1][0] + w[2][0] * xm[2][0] + w[3][0] * x0 + bias[0]);
                const float a1 = silu_f(w[0][1] * xm[0][1] + w[1][1] * xm[1][1] + w[2][1] * xm[2][1] + w[3][1] * x1 + bias[1]);
                if (ch < 512) { *(unsigned*)(XC + (size_t)(row0 + r) * 512 + ch) = pk2(a0, a1); const float dt = sdt[r * 8 + (ch >> 6)]; f32x2 d = {a0 * dt, a1 * dt}; *(f32x2*)(DTX + (size_t)(row0 + r) * 512 + ch) = d; }
                else { f32x2 d = {a0, a1}; *(f32x2*)(BC + (size_t)(row0 + r) * 512 + (ch - 512)) = d; }
                xm[0][0] = xm[1][0]; xm[1][0] = xm[2][0]; xm[2][0] = x0; xm[0][1] = xm[1][1]; xm[1][1] = xm[2][1]; xm[2][1] = x1;
            }
        }
        if (tid < 384) {
            const int ch = 2 * tid; const int col = C_GQ + ch;
            float w[4][2];
#pragma unroll
            for (int k = 0; k < 4; ++k) { w[k][0] = gcw[k * 768 + ch]; w[k][1] = gcw[k * 768 + ch + 1]; }
            float xm[3][2];
#pragma unroll
            for (int k = 0; k < 3; ++k) { unsigned u = 0; if (has_halo) u = *(const unsigned*)(Hb + (size_t)(row0 - 3 + k) * DINP + col); xm[k][0] = bf2f(u & 0xffffu); xm[k][1] = bf2f(u >> 16); }
#pragma unroll 4
            for (int r = 0; r < 64; ++r) {
                const unsigned u = *(const unsigned*)(Hb + (size_t)(row0 + r) * DINP + col); const float x0 = bf2f(u & 0xffffu), x1 = bf2f(u >> 16);
                const float a0 = silu_f(w[0][0] * xm[0][0] + w[1][0] * xm[1][0] + w[2][0] * xm[2][0] + w[3][0] * x0);
                const float a1 = silu_f(w[0][1] * xm[0][1] + w[1][1] * xm[1][1] + w[2][1] * xm[2][1] + w[3][1] * x1);
                if (ch < 512) { qk[r * 512 + ch] = a0; qk[r * 512 + ch + 1] = a1; }
                else { const float beta = sbeta[r * 4 + ((ch - 512) >> 6)]; *(unsigned*)(GV + (size_t)(row0 + r) * 256 + (ch - 512)) = pk2(a0 * beta, a1 * beta); }
                xm[0][0] = xm[1][0]; xm[1][0] = xm[2][0]; xm[2][0] = x0; xm[0][1] = xm[1][1]; xm[1][1] = xm[2][1]; xm[2][1] = x1;
            }
        }
        __syncthreads();
        for (int it = wave * 64; it < wave * 64 + 64; ++it) {
            const int r = it >> 3, hd = it & 7; const float v = qk[r * 512 + hd * 64 + lane];
            const float ss = wave_sum(v * v); const float sc = rsqrtf(ss + 1e-6f) * (hd < 4 ? 0.125f : 1.0f);
            GQK[(size_t)(row0 + r) * 512 + hd * 64 + lane] = v * sc;
        }
        __syncthreads();
    }
}

__device__ __forceinline__ void mamba_task(const Args& a, int task, int lane, LAS float* red) {
    const float* BC = (const float*)(a.ws + WS_BC); const float* DTX = (const float*)(a.ws + WS_DTX); const float* SC = (const float*)(a.ws + WS_SC); float* YM = (float*)(a.ws + WS_YM);
    const int b = task >> 7, h = (task >> 4) & 7, pq = task & 15, g = h >> 2;
    const size_t rowb = (size_t)b * SEQ;
    const f32x2* Bp = (const f32x2*)(BC + rowb * 512 + g * 128) + lane;
    const f32x2* Cp = (const f32x2*)(BC + rowb * 512 + 256 + g * 128) + lane;
    const f32x4* Xp = (const f32x4*)(DTX + rowb * 512 + h * 64 + 4 * pq);
    const float* Ap = SC + rowb * 32 + 8 + h;
    float* Yp = YM + rowb * 512 + h * 64 + 4 * pq;
    constexpr int T = 4, NB = 4;
    f32x2 Bb[NB][T], Cb[NB][T]; f32x4 Xb[NB][T]; float Ab[NB][T];
#pragma unroll
    for (int k = 0; k < NB; ++k)
#pragma unroll
        for (int i = 0; i < T; ++i) { const size_t t = k * T + i; Bb[k][i] = Bp[t * 256]; Cb[k][i] = Cp[t * 256]; Xb[k][i] = Xp[t * 128]; Ab[k][i] = Ap[t * 32]; }
    f32x2 hs[4] = {{0.f, 0.f}, {0.f, 0.f}, {0.f, 0.f}, {0.f, 0.f}};
    LAS float* wr_ = red + (lane >> 4) * 20 + (lane & 15);
    const LAS float* rd_ = red + lane * 20;
    for (int t0 = 0; t0 < SEQ; t0 += NB * T) {
#pragma unroll
        for (int k = 0; k < NB; ++k) {
            if (t0 + k * T >= SEQ) break;
#pragma unroll
            for (int i = 0; i < T; ++i) {
                const f32x2 dA = {Ab[k][i], Ab[k][i]};
#pragma unroll
                for (int j = 0; j < 4; ++j) {
                    const f32x2 dx = {Xb[k][i][j], Xb[k][i][j]};
                    hs[j] = hs[j] * dA + dx * Bb[k][i];
                    const f32x2 yp = Cb[k][i] * hs[j];
                    wr_[(i * 4 + j) * 80] = yp.x + yp.y;
                }
            }
            if (t0 + (NB + k) * T < SEQ) {
#pragma unroll
                for (int i = 0; i < T; ++i) { const size_t t = t0 + (NB + k) * T + i; Bb[k][i] = Bp[t * 256]; Cb[k][i] = Cp[t * 256]; Xb[k][i] = Xp[t * 128]; Ab[k][i] = Ap[t * 32]; }
            }
            asm volatile("s_waitcnt lgkmcnt(0)" ::: "memory");
            float s = 0.f;
#pragma unroll
            for (int q = 0; q < 4; ++q) { const f32x4 v = *(const LAS f32x4*)(rd_ + 4 * q); s += (v.x + v.y) + (v.z + v.w); }
            asm volatile("s_waitcnt lgkmcnt(0)" ::: "memory");
            s += dpp_mov<0xB1>(s); s += dpp_mov<0x4E>(s);
            if ((lane & 3) == 0) { const int v = lane >> 2; Yp[(size_t)(t0 + k * T + (v >> 2)) * 512 + (v & 3)] = s; }
        }
    }
}
__device__ __forceinline__ void delta_task(const Args& a, int task, int lane) {
    const float* GQK = (const float*)(a.ws + WS_GQK); const bf16_t* GV = (const bf16_t*)(a.ws + WS_GV); const float* SC = (const float*)(a.ws + WS_SC); float* OD = (float*)(a.ws + WS_OD);
    const int b = task >> 6, hh = (task >> 4) & 3, dv = 4 * (task & 15) + (lane >> 4), dkq = lane & 15;
    const size_t rowb = (size_t)b * SEQ;
    const f32x4* Qp = (const f32x4*)(GQK + rowb * 512 + hh * 64) + dkq;
    const f32x4* Kp = Qp + 64;
    const bf16_t* Vp = GV + rowb * 256 + hh * 64 + dv;
    const f32x2* Sp = (const f32x2*)(SC + rowb * 32 + 16 + 2 * hh);
    float* Op = OD + rowb * 256 + hh * 64 + dv;
    constexpr int T = 4, NB = 4;
    f32x4 qb[NB][T], kb[NB][T]; unsigned short vb[NB][T]; f32x2 sdb[NB][T];
#pragma unroll
    for (int k = 0; k < NB; ++k)
#pragma unroll
        for (int i = 0; i < T; ++i) { const size_t t = k * T + i; qb[k][i] = Qp[t * 128]; kb[k][i] = Kp[t * 128]; vb[k][i] = Vp[t * 256]; sdb[k][i] = Sp[t * 16]; }
    f32x4 S = {0.f, 0.f, 0.f, 0.f};
    for (int t0 = 0; t0 < SEQ; t0 += NB * T) {
#pragma unroll
        for (int kk = 0; kk < NB; ++kk) {
            if (t0 + kk * T >= SEQ) break;
            float ov[T];
#pragma unroll
            for (int i = 0; i < T; ++i) {
                const f32x4 k = kb[kk][i], q = qb[kk][i]; const float bv = bf2f(vb[kk][i]), bd = sdb[kk][i].x, dec = sdb[kk][i].y;
                float ks = (S.x * k.x + S.y * k.y) + (S.z * k.z + S.w * k.w);
                ks += dpp_mov<0xB1>(ks); ks += dpp_mov<0x4E>(ks); ks += dpp_mov<0x141>(ks); ks += dpp_mov<0x140>(ks);
                const float vnew = bv - bd * ks;
                S = S * dec + k * vnew;
                float o = (S.x * q.x + S.y * q.y) + (S.z * q.z + S.w * q.w);
                o += dpp_mov<0xB1>(o); o += dpp_mov<0x4E>(o); o += dpp_mov<0x141>(o); o += dpp_mov<0x140>(o);
                ov[i] = o;
            }
            if (t0 + (NB + kk) * T < SEQ) {
#pragma unroll
                for (int i = 0; i < T; ++i) { const size_t t = t0 + (NB + kk) * T + i; qb[kk][i] = Qp[t * 128]; kb[kk][i] = Kp[t * 128]; vb[kk][i] = Vp[t * 256]; sdb[kk][i] = Sp[t * 16]; }
            }
            { float o = ov[0]; o = (dkq == 1) ? ov[1] : o; o = (dkq == 2) ? ov[2] : o; o = (dkq == 3) ? ov[3] : o;
              if (dkq < 4) Op[(size_t)(t0 + kk * T + dkq) * 256] = o; }
        }
    }
}

constexpr int AT_BASE = 16384, AT_K = AT_BASE, AT_V = AT_K + 16384, AT_WS = AT_V + 17408, AT_OST = AT_WS + 512, AT_END = AT_OST + 4 * 32 * 65 * 4;
constexpr int AT_CNT = 131072 + 512;
static_assert(AT_END <= 131072, "attention LDS");
__device__ __forceinline__ void sw_bar4(LAS unsigned* cnt, unsigned& gen, int lane) {
    asm volatile("s_waitcnt vmcnt(0) lgkmcnt(0)" ::: "memory");
    gen += 4u;
    if (lane == 0) __hip_atomic_fetch_add(cnt, 1u, __ATOMIC_RELAXED, __HIP_MEMORY_SCOPE_WORKGROUP);
    while (__hip_atomic_load(cnt, __ATOMIC_RELAXED, __HIP_MEMORY_SCOPE_WORKGROUP) < gen) __builtin_amdgcn_s_sleep(1);
    asm volatile("" ::: "memory");
}
__device__ __forceinline__ void attn_unit(const Args& a, int l, int b, int h, int c64, float lam, float lam_init, LAS unsigned char* lds, unsigned& gen) {
    int tid_l = threadIdx.x; asm volatile("" : "+v"(tid_l)); const int tid = tid_l - 256, lane = tid & 63, wid = __builtin_amdgcn_readfirstlane(tid >> 6), r32 = lane & 31, hi = lane >> 5, map = wid >> 1, wq = wid & 1;
    LAS unsigned* cnt = (LAS unsigned*)(lds + AT_CNT);
    const bf16_t* Hb = (const bf16_t*)(a.ws + WS_HB); bf16_t* MIX = (bf16_t*)(a.ws + WS_MIX);
    const size_t rowb = (size_t)b * SEQ; const int q0 = c64 * 64;
    bf16x8 qr[2];
    { const bf16_t* qp = Hb + (rowb + q0 + wq * 32 + r32) * DINP + C_DQ + h * 64 + map * 32 + hi * 8; qr[0] = *(const bf16x8*)qp; qr[1] = *(const bf16x8*)(qp + 16); }
    const int NT = c64 + 1;
    const int kkv = tid >> 2, kc = tid & 3;
    const bf16_t* ksrc = Hb + (rowb + kkv) * DINP + C_DK + h * 64 + kc * 8;
    const int kdst = AT_K + ((((kc >> 1) * 2 + (kkv >> 5)) * 2 + (kc & 1)) * 512) + (kkv & 31) * 16;
    const bf16_t* vsrc = Hb + (rowb + lane) * DINP + C_DV + h * 64 + wid * 8;
    const int vdst = AT_V + ((wid * 8) * 68 + lane) * 2;
    u32x4 kreg0 = *(const u32x4*)ksrc, kreg1 = *(const u32x4*)(ksrc + 32), vreg0 = *(const u32x4*)vsrc, vreg1 = *(const u32x4*)(vsrc + 32);
#define AT_WV(vp_, vreg) do { vp_[0 * 68] = (unsigned short)(vreg.x & 0xffffu); vp_[1 * 68] = (unsigned short)(vreg.x >> 16); vp_[2 * 68] = (unsigned short)(vreg.y & 0xffffu); vp_[3 * 68] = (unsigned short)(vreg.y >> 16); \
        vp_[4 * 68] = (unsigned short)(vreg.z & 0xffffu); vp_[5 * 68] = (unsigned short)(vreg.z >> 16); vp_[6 * 68] = (unsigned short)(vreg.w & 0xffffu); vp_[7 * 68] = (unsigned short)(vreg.w >> 16); } while (0)
#define AT_WRITE(buf) do { *(LAS u32x4*)(lds + (buf) * 8192 + kdst) = kreg0; *(LAS u32x4*)(lds + (buf) * 8192 + 4096 + kdst) = kreg1; \
        LAS unsigned short* vp0_ = (LAS unsigned short*)(lds + (buf) * 8704 + vdst); AT_WV(vp0_, vreg0); LAS unsigned short* vp1_ = vp0_ + 32 * 68; AT_WV(vp1_, vreg1); } while (0)
    AT_WRITE(0);
    sw_bar4(cnt, gen, lane);
    float m_run = -INFINITY, l_run = 0.f; f32x16 o0 = {}, o1 = {};
    LAS float* wsf = (LAS float*)(lds + AT_WS) + wid * 32;
    const float c = 0.25503486164919736f;
    for (int t = 0; t < NT; ++t) {
        if (t + 1 < NT) { const bf16_t* kp = ksrc + (size_t)(t + 1) * 64 * DINP; const bf16_t* vp = vsrc + (size_t)(t + 1) * 64 * DINP;
            kreg0 = *(const u32x4*)kp; kreg1 = *(const u32x4*)(kp + 32); vreg0 = *(const u32x4*)vp; vreg1 = *(const u32x4*)(vp + 32); }
        {
            const int buf = t & 1;
            const LAS unsigned char* Kb = lds + buf * 8192 + AT_K + map * 4096;
            f32x16 p0 = {}, p1 = {};
#pragma unroll
            for (int d0 = 0; d0 < 2; ++d0) {
                const bf16x8 a0 = *(const LAS bf16x8*)(Kb + ((d0 * 2 + 0) * 2 + hi) * 512 + r32 * 16);
                const bf16x8 a1 = *(const LAS bf16x8*)(Kb + ((d0 * 2 + 1) * 2 + hi) * 512 + r32 * 16);
                p0 = __builtin_amdgcn_mfma_f32_32x32x16_bf16(a0, qr[d0], p0, 0, 0, 0);
                p1 = __builtin_amdgcn_mfma_f32_32x32x16_bf16(a1, qr[d0], p1, 0, 0, 0);
            }
            float mx = p0[0];
#pragma unroll
            for (int r = 1; r < 16; ++r) mx = fmaxf(mx, p0[r]);
#pragma unroll
            for (int r = 0; r < 16; ++r) mx = fmaxf(mx, p1[r]);
            mx = fmaxf(mx, xor32(mx));
            const float m_new = fmaxf(m_run, mx * c);
            const float alpha = exp2f(m_run - m_new);
            m_run = m_new;
            float rs = 0.f;
#pragma unroll
            for (int r = 0; r < 16; ++r) { p0[r] = exp2f(p0[r] * c - m_new); rs += p0[r]; }
#pragma unroll
            for (int r = 0; r < 16; ++r) { p1[r] = exp2f(p1[r] * c - m_new); rs += p1[r]; }
            l_run = l_run * alpha + rs;
            if (__any(alpha != 1.0f)) {
                if (hi == 0) wsf[r32] = alpha;
                asm volatile("s_waitcnt lgkmcnt(0)" ::: "memory");
#pragma unroll
                for (int r = 0; r < 16; ++r) { const float f = wsf[(r & 3) + 8 * (r >> 2) + 4 * hi]; o0[r] *= f; o1[r] *= f; }
            }
            bf16x8 pa[4];
#pragma unroll
            for (int ks = 0; ks < 4; ++ks) { u32x4 w;
                if (ks < 2) { const int o = 8 * ks; w.x = pk2(p0[o], p0[o + 1]); w.y = pk2(p0[o + 2], p0[o + 3]); w.z = pk2(p0[o + 4], p0[o + 5]); w.w = pk2(p0[o + 6], p0[o + 7]); }
                else { const int o = 8 * (ks - 2); w.x = pk2(p1[o], p1[o + 1]); w.y = pk2(p1[o + 2], p1[o + 3]); w.z = pk2(p1[o + 4], p1[o + 5]); w.w = pk2(p1[o + 6], p1[o + 7]); }
                pa[ks] = __builtin_bit_cast(bf16x8, w); }
            const LAS unsigned char* Vb = lds + buf * 8704 + AT_V;
#pragma unroll
            for (int ks = 0; ks < 4; ++ks) { const int kvb = 16 * (ks & 1) + 32 * (ks >> 1) + 4 * hi;
                { const LAS unsigned char* vp = Vb + (r32 * 68 + kvb) * 2; const u32x2 lo = *(const LAS u32x2*)vp, hh2 = *(const LAS u32x2*)(vp + 16);
                  u32x4 w = {lo.x, lo.y, hh2.x, hh2.y}; o0 = __builtin_amdgcn_mfma_f32_32x32x16_bf16(pa[ks], __builtin_bit_cast(bf16x8, w), o0, 0, 0, 0); }
                { const LAS unsigned char* vp = Vb + ((32 + r32) * 68 + kvb) * 2; const u32x2 lo = *(const LAS u32x2*)vp, hh2 = *(const LAS u32x2*)(vp + 16);
                  u32x4 w = {lo.x, lo.y, hh2.x, hh2.y}; o1 = __builtin_amdgcn_mfma_f32_32x32x16_bf16(pa[ks], __builtin_bit_cast(bf16x8, w), o1, 0, 0, 0); }
            }
        }
        if (t + 1 < NT) AT_WRITE((t + 1) & 1);
        sw_bar4(cnt, gen, lane);
    }
#undef AT_WRITE
#undef AT_WV
    { const float lt = l_run + xor32(l_run);
      if (hi == 0) wsf[r32] = 1.0f / lt;
      asm volatile("s_waitcnt lgkmcnt(0)" ::: "memory");
      LAS float* ost = (LAS float*)(lds + AT_OST) + wid * (32 * 65);
#pragma unroll
      for (int r = 0; r < 16; ++r) { const int q = (r & 3) + 8 * (r >> 2) + 4 * hi; const float f = wsf[q]; ost[q * 65 + r32] = o0[r] * f; ost[q * 65 + 32 + r32] = o1[r] * f; } }
    sw_bar4(cnt, gen, lane);
    if (wid < 2) {
        const int q = lane >> 1, dh = lane & 1;
        const LAS float* o1p = (const LAS float*)(lds + AT_OST) + wid * (32 * 65) + q * 65 + dh * 32; const LAS float* o2p = o1p + 2 * (32 * 65);
        const float* sw = a.in[7] + l * 64 + dh * 32;
        float v[32]; float ss = 0.f;
#pragma unroll
        for (int e = 0; e < 32; ++e) { v[e] = o1p[e] - lam * o2p[e]; ss += v[e] * v[e]; }
        ss += dpp_mov<0xB1>(ss);
        const float rinv = rsqrtf(ss * (1.f / 64.f) + LN_EPS) * (1.f - lam_init);
        bf16_t* op = MIX + (rowb + q0 + wid * 32 + q) * 1024 + h * 64 + dh * 32;
#pragma unroll
        for (int e8 = 0; e8 < 4; ++e8) { u32x4 w; const int e = e8 * 8;
            w.x = pk2(v[e] * rinv * sw[e], v[e + 1] * rinv * sw[e + 1]); w.y = pk2(v[e + 2] * rinv * sw[e + 2], v[e + 3] * rinv * sw[e + 3]);
            w.z = pk2(v[e + 4] * rinv * sw[e + 4], v[e + 5] * rinv * sw[e + 5]); w.w = pk2(v[e + 6] * rinv * sw[e + 6], v[e + 7] * rinv * sw[e + 7]);
            *(u32x4*)(op + e) = w; }
    }
    sw_bar4(cnt, gen, lane);
}

constexpr int A8_K = 0, A8_V = 16384, A8_WS = 16384 + 17408, A8_OST = A8_WS + 1024, A8_END = A8_OST + 8 * 32 * 65 * 4;
static_assert(A8_END <= 131072, "attention LDS");
__device__ __forceinline__ void attn_unit8(const Args& a, int l, int b, int h, int qb, float lam, float lam_init, LAS unsigned char* lds) {
    int tid_l = threadIdx.x; asm volatile("" : "+v"(tid_l)); const int tid = tid_l, lane = tid & 63, wid = __builtin_amdgcn_readfirstlane(tid >> 6), r32 = lane & 31, hi = lane >> 5, map = wid >> 2, wq = wid & 3;
    const bf16_t* Hb = (const bf16_t*)(a.ws + WS_HB); bf16_t* MIX = (bf16_t*)(a.ws + WS_MIX);
    const size_t rowb = (size_t)b * SEQ; const int q0 = qb * 128;
    bf16x8 qr[2];
    { const bf16_t* qp = Hb + (rowb + q0 + wq * 32 + r32) * DINP + C_DQ + h * 64 + map * 32 + hi * 8; qr[0] = *(const bf16x8*)qp; qr[1] = *(const bf16x8*)(qp + 16); }
    const int NT = 2 * qb + 2; const int my_last = 2 * qb + (wq >> 1);
    const int kmap = tid >> 8, kkv = (tid & 255) >> 2, kc = tid & 3;
    const bf16_t* ksrc = Hb + (rowb + kkv) * DINP + C_DK + h * 64 + kmap * 32 + kc * 8;
    const int kdst = A8_K + kmap * 4096 + ((((kc >> 1) * 2 + (kkv >> 5)) * 2 + (kc & 1)) * 512) + (kkv & 31) * 16;
    const bf16_t* vsrc = Hb + (rowb + lane) * DINP + C_DV + h * 64 + wid * 8;
    const int vdst = A8_V + ((wid * 8) * 68 + lane) * 2;
    u32x4 kreg = *(const u32x4*)ksrc, vreg = *(const u32x4*)vsrc;
#define A8_WRITE(buf) do { *(LAS u32x4*)(lds + (buf) * 8192 + kdst) = kreg; LAS unsigned short* vp_ = (LAS unsigned short*)(lds + (buf) * 8704 + vdst); \
        vp_[0 * 68] = (unsigned short)(vreg.x & 0xffffu); vp_[1 * 68] = (unsigned short)(vreg.x >> 16); vp_[2 * 68] = (unsigned short)(vreg.y & 0xffffu); vp_[3 * 68] = (unsigned short)(vreg.y >> 16); \
        vp_[4 * 68] = (unsigned short)(vreg.z & 0xffffu); vp_[5 * 68] = (unsigned short)(vreg.z >> 16); vp_[6 * 68] = (unsigned short)(vreg.w & 0xffffu); vp_[7 * 68] = (unsigned short)(vreg.w >> 16); } while (0)
    A8_WRITE(0);
    __syncthreads();
    float m_run = -INFINITY, l_run = 0.f; f32x16 o0 = {}, o1 = {};
    LAS float* wsf = (LAS float*)(lds + A8_WS) + wid * 32;
    const float c = 0.25503486164919736f;
    for (int t = 0; t < NT; ++t) {
        if (t + 1 < NT) { kreg = *(const u32x4*)(ksrc + (size_t)(t + 1) * 64 * DINP); vreg = *(const u32x4*)(vsrc + (size_t)(t + 1) * 64 * DINP); }
        if (t <= my_last) {
            const int buf = t & 1;
            const LAS unsigned char* Kb = lds + buf * 8192 + A8_K + map * 4096;
            f32x16 p0 = {}, p1 = {};
#pragma unroll
            for (int d0 = 0; d0 < 2; ++d0) {
                const bf16x8 a0 = *(const LAS bf16x8*)(Kb + ((d0 * 2 + 0) * 2 + hi) * 512 + r32 * 16);
                const bf16x8 a1 = *(const LAS bf16x8*)(Kb + ((d0 * 2 + 1) * 2 + hi) * 512 + r32 * 16);
                p0 = __builtin_amdgcn_mfma_f32_32x32x16_bf16(a0, qr[d0], p0, 0, 0, 0);
                p1 = __builtin_amdgcn_mfma_f32_32x32x16_bf16(a1, qr[d0], p1, 0, 0, 0);
            }
            float mx = p0[0];
#pragma unroll
            for (int r = 1; r < 16; ++r) mx = fmaxf(mx, p0[r]);
#pragma unroll
            for (int r = 0; r < 16; ++r) mx = fmaxf(mx, p1[r]);
            mx = fmaxf(mx, xor32(mx));
            const float m_new = fmaxf(m_run, mx * c);
            const float alpha = exp2f(m_run - m_new);
            m_run = m_new;
            float rs = 0.f;
#pragma unroll
            for (int r = 0; r < 16; ++r) { p0[r] = exp2f(p0[r] * c - m_new); rs += p0[r]; }
#pragma unroll
            for (int r = 0; r < 16; ++r) { p1[r] = exp2f(p1[r] * c - m_new); rs += p1[r]; }
            l_run = l_run * alpha + rs;
            if (__any(alpha != 1.0f)) {
                if (hi == 0) wsf[r32] = alpha;
                asm volatile("s_waitcnt lgkmcnt(0)" ::: "memory");
#pragma unroll
                for (int r = 0; r < 16; ++r) { const float f = wsf[(r & 3) + 8 * (r >> 2) + 4 * hi]; o0[r] *= f; o1[r] *= f; }
            }
            bf16x8 pa[4];
#pragma unroll
            for (int ks = 0; ks < 4; ++ks) { u32x4 w;
                if (ks < 2) { const int o = 8 * ks; w.x = pk2(p0[o], p0[o + 1]); w.y = pk2(p0[o + 2], p0[o + 3]); w.z = pk2(p0[o + 4], p0[o + 5]); w.w = pk2(p0[o + 6], p0[o + 7]); }
                else { const int o = 8 * (ks - 2); w.x = pk2(p1[o], p1[o + 1]); w.y = pk2(p1[o + 2], p1[o + 3]); w.z = pk2(p1[o + 4], p1[o + 5]); w.w = pk2(p1[o + 6], p1[o + 7]); }
                pa[ks] = __builtin_bit_cast(bf16x8, w); }
            const LAS unsigned char* Vb = lds + buf * 8704 + A8_V;
#pragma unroll
            for (int ks = 0; ks < 4; ++ks) { const int kvb = 16 * (ks & 1) + 32 * (ks >> 1) + 4 * hi;
                { const LAS unsigned char* vp = Vb + (r32 * 68 + kvb) * 2; const u32x2 lo = *(const LAS u32x2*)vp, hh2 = *(const LAS u32x2*)(vp + 16);
                  u32x4 w = {lo.x, lo.y, hh2.x, hh2.y}; o0 = __builtin_amdgcn_mfma_f32_32x32x16_bf16(pa[ks], __builtin_bit_cast(bf16x8, w), o0, 0, 0, 0); }
                { const LAS unsigned char* vp = Vb + ((32 + r32) * 68 + kvb) * 2; const u32x2 lo = *(const LAS u32x2*)vp, hh2 = *(const LAS u32x2*)(vp + 16);
                  u32x4 w = {lo.x, lo.y, hh2.x, hh2.y}; o1 = __builtin_amdgcn_mfma_f32_32x32x16_bf16(pa[ks], __builtin_bit_cast(bf16x8, w), o1, 0, 0, 0); }
            }
        }
        if (t + 1 < NT) A8_WRITE((t + 1) & 1);
        __syncthreads();
    }
#undef A8_WRITE
    { const float lt = l_run + xor32(l_run);
      if (hi == 0) wsf[r32] = 1.0f / lt;
      asm volatile("s_waitcnt lgkmcnt(0)" ::: "memory");
      LAS float* ost = (LAS float*)(lds + A8_OST) + wid * (32 * 65);
#pragma unroll
      for (int r = 0; r < 16; ++r) { const int q = (r & 3) + 8 * (r >> 2) + 4 * hi; const float f = wsf[q]; ost[q * 65 + r32] = o0[r] * f; ost[q * 65 + 32 + r32] = o1[r] * f; } }
    __syncthreads();
    if (wid < 4) {
        const int q = lane >> 1, dh = lane & 1;
        const LAS float* o1p = (const LAS float*)(lds + A8_OST) + wid * (32 * 65) + q * 65 + dh * 32; const LAS float* o2p = o1p + 4 * (32 * 65);
        const float* sw = a.in[7] + l * 64 + dh * 32;
        float v[32]; float ss = 0.f;
#pragma unroll
        for (int e = 0; e < 32; ++e) { v[e] = o1p[e] - lam * o2p[e]; ss += v[e] * v[e]; }
        ss += dpp_mov<0xB1>(ss);
        const float rinv = rsqrtf(ss * (1.f / 64.f) + LN_EPS) * (1.f - lam_init);
        bf16_t* op = MIX + (rowb + q0 + wid * 32 + q) * 1024 + h * 64 + dh * 32;
#pragma unroll
        for (int e8 = 0; e8 < 4; ++e8) { u32x4 w; const int e = e8 * 8;
            w.x = pk2(v[e] * rinv * sw[e], v[e + 1] * rinv * sw[e + 1]); w.y = pk2(v[e + 2] * rinv * sw[e + 2], v[e + 3] * rinv * sw[e + 3]);
            w.z = pk2(v[e + 4] * rinv * sw[e + 4], v[e + 5] * rinv * sw[e + 5]); w.w = pk2(v[e + 6] * rinv * sw[e + 6], v[e + 7] * rinv * sw[e + 7]);
            *(u32x4*)(op + e) = w; }
    }
    __syncthreads();
}

__device__ __forceinline__ void post_phase(const Args& a, int l) {
    int tid_l = threadIdx.x; asm volatile("" : "+v"(tid_l)); const int tid = tid_l, lane = tid & 63, wave = __builtin_amdgcn_readfirstlane(tid >> 6); const int gw = blockIdx.x * NWAVES + wave, NGW = gridDim.x * NWAVES; (void)gw; (void)NGW; (void)lane; (void)wave;
    const bf16_t* Hb = (const bf16_t*)(a.ws + WS_HB); const bf16_t* XC = (const bf16_t*)(a.ws + WS_XC); const float* YM = (const float*)(a.ws + WS_YM); const float* OD = (const float*)(a.ws + WS_OD);
    bf16_t* MIX = (bf16_t*)(a.ws + WS_MIX);
    const float Dh = a.in[12][l * 8 + (lane >> 3)];
    f32x4 nw0 = *(const f32x4*)(a.in[13] + l * 512 + 8 * lane), nw1 = *(const f32x4*)(a.in[13] + l * 512 + 8 * lane + 4);
    const f32x4 gw4 = *(const f32x4*)(a.in[17] + l * 64 + 4 * (lane & 15));
    for (int row = gw; row < M; row += NGW) {
        {   const f32x4 y0 = *(const f32x4*)(YM + (size_t)row * 512 + 8 * lane), y1 = *(const f32x4*)(YM + (size_t)row * 512 + 8 * lane + 4);
            const u32x4 xc = *(const u32x4*)(XC + (size_t)row * 512 + 8 * lane); const u32x4 z = *(const u32x4*)(Hb + (size_t)row * DINP + C_MZ + 8 * lane);
            float y[8] = {y0[0], y0[1], y0[2], y0[3], y1[0], y1[1], y1[2], y1[3]}; const unsigned xw[4] = {xc.x, xc.y, xc.z, xc.w}, zw[4] = {z.x, z.y, z.z, z.w};
            float ss = 0.f;
#pragma unroll
            for (int j = 0; j < 4; ++j) { y[2 * j] = (y[2 * j] + Dh * bf2f(xw[j] & 0xffffu)) * silu_f(bf2f(zw[j] & 0xffffu)); y[2 * j + 1] = (y[2 * j + 1] + Dh * bf2f(xw[j] >> 16)) * silu_f(bf2f(zw[j] >> 16));
                ss += y[2 * j] * y[2 * j] + y[2 * j + 1] * y[2 * j + 1]; }
            ss += dpp_mov<0xB1>(ss); ss += dpp_mov<0x4E>(ss); ss += dpp_mov<0x141>(ss); ss += dpp_mov<0x140>(ss);
            { auto rr = __builtin_amdgcn_permlane16_swap(__float_as_uint(ss), __float_as_uint(ss), false, false); ss = __uint_as_float(rr[0]) + __uint_as_float(rr[1]); }
            const float r = rsqrtf(ss * (1.f / 256.f) + LN_EPS);
            u32x4 w; w.x = pk2(y[0] * r * nw0[0], y[1] * r * nw0[1]); w.y = pk2(y[2] * r * nw0[2], y[3] * r * nw0[3]); w.z = pk2(y[4] * r * nw1[0], y[5] * r * nw1[1]); w.w = pk2(y[6] * r * nw1[2], y[7] * r * nw1[3]);
            *(u32x4*)(MIX + (size_t)row * 1024 + 256 + 8 * lane) = w; }
        {   const f32x4 o = *(const f32x4*)(OD + (size_t)row * 256 + 4 * lane); const u32x2 gz = *(const u32x2*)(Hb + (size_t)row * DINP + C_GZ + 4 * lane);
            float ss = o[0] * o[0] + o[1] * o[1] + o[2] * o[2] + o[3] * o[3];
            ss += dpp_mov<0xB1>(ss); ss += dpp_mov<0x4E>(ss); ss += dpp_mov<0x141>(ss); ss += dpp_mov<0x140>(ss);
            const float r = rsqrtf(ss * (1.f / 64.f) + LN_EPS);
            u32x2 w; w.x = pk2(o[0] * r * gw4[0] * silu_f(bf2f(gz.x & 0xffffu)), o[1] * r * gw4[1] * silu_f(bf2f(gz.x >> 16)));
            w.y = pk2(o[2] * r * gw4[2] * silu_f(bf2f(gz.y & 0xffffu)), o[3] * r * gw4[3] * silu_f(bf2f(gz.y >> 16)));
            *(u32x2*)(MIX + (size_t)row * 1024 + 768 + 4 * lane) = w; }
    }
}
#ifndef REP_REC
#define REP_REC 1
#endif
#ifndef REP_ATTN
#define REP_ATTN 1
#endif
#ifndef REP_SYNC
#define REP_SYNC 1
#endif
#define GSYNC() do { for (int rs_ = 0; rs_ < REP_SYNC; ++rs_) xcd_barrier(bar); } while (0)
__global__ void __launch_bounds__(512, 2) fwd_megakernel(Args a) {
    extern __shared__ __attribute__((aligned(16))) unsigned char lds_raw[];
    LAS unsigned char* lds = (LAS unsigned char*)lds_raw;
    cg::grid_group grid = cg::this_grid();
    const int G = gridDim.x;
    unsigned char* ws = a.ws;
    float* X = a.out; bf16_t* XN = (bf16_t*)(ws + WS_XN); bf16_t* HB = (bf16_t*)(ws + WS_HB); bf16_t* MIX = (bf16_t*)(ws + WS_MIX);
    const float beta_half = 0.5f;

    for (int u = threadIdx.x; u < 64; u += 512) ((LAS unsigned*)(lds + 131072))[u] = 0u;
    __syncthreads();
    XcdBarrier bar = xcd_barrier_post((unsigned*)a.ws, (volatile LAS unsigned*)(lds + 131072) + 8);
#ifndef NO_PRO
    prologue(a);
    convert_layer(a, 0, lds);
#endif
    grid.sync();

    for (int l = 0; l < DEPTH; ++l) {
        { pg8::Gemm g{XN, (const bf16_t*)(ws + WS_WGU1), M, NGU, D}; pg8::StaticOrder S; S.init(M, NGU, G, (int)blockIdx.x); pg8::EpiSwiglu E{HB};
          pg8::gemm_phase<pg8::EpiSwiglu, pg8::StaticOrder, true, true>(lds, g, S, E); }
        GSYNC();
        { pg8::Gemm g{HB, (const bf16_t*)(ws + WS_WD1), M, D, DFF}; pg8::StaticOrder S; S.init(M, D, G, (int)blockIdx.x); pg8::EpiResid E{X, ALPHA, beta_half};
          pg8::gemm_phase<pg8::EpiResid, pg8::StaticOrder, true, true>(lds, g, S, E); }
        GSYNC();
        ln_rows(X, a.in[3] + l * D, a.in[4] + l * D, XN);
        GSYNC();
        { pg8::Gemm g{XN, (const bf16_t*)(ws + WS_WIN), M, DINP, D}; pg8::StaticOrder S; S.init(M, DINP, G, (int)blockIdx.x); pg8::EpiInproj E{HB, (const float*)(ws + WS_ROPE)};
          pg8::gemm_phase<pg8::EpiInproj, pg8::StaticOrder, true, true>(lds, g, S, E); }
        GSYNC();
#ifndef NO_PREP
        prep_phase(a, l, lds);
#endif
        GSYNC();
        {
            int tid_l = threadIdx.x; asm volatile("" : "+v"(tid_l)); const int lane = tid_l & 63, wave = __builtin_amdgcn_readfirstlane(tid_l >> 6);
            if (wave < 3) {
                for (int tb = blockIdx.x; tb < 256; tb += G) {
                    if (wave == 0) delta_task(a, tb, lane);
                    else mamba_task(a, tb * 2 + (wave - 1), lane, (LAS float*)(lds + (wave - 1) * 5120));
                }
            }
            __syncthreads();
            const float* lp = a.in[6] + l * 128; float d1 = 0.f, d2 = 0.f;
            for (int i = 0; i < 32; ++i) { d1 += lp[i] * lp[32 + i]; d2 += lp[64 + i] * lp[96 + i]; }
            const float lam_init = 0.8f - 0.6f * __expf(-0.3f * (float)l);
            const float lam = __expf(d1) - __expf(d2) + lam_init;
            for (int u = blockIdx.x; u < 512; u += G) {
                const int j = u >> 8, v = u & 255, bh = v >> 4, s = v & 15, qb = j == 0 ? s : 31 - s;
                attn_unit8(a, l, bh >> 2, bh & 3, qb, lam, lam_init, lds);
            }
        }
        GSYNC();
#ifndef NO_POST
        post_phase(a, l);
#endif
        GSYNC();
        { pg8::Gemm g{MIX, (const bf16_t*)(ws + WS_WOUT), M, D, D}; pg8::StaticOrder S; S.init(M, D, G, (int)blockIdx.x); pg8::EpiResid E{X, ALPHA, 1.0f};
          pg8::gemm_phase<pg8::EpiResid, pg8::StaticOrder, true, true>(lds, g, S, E); }
        GSYNC();
        ln_rows(X, a.in[19] + l * D, a.in[20] + l * D, XN);
        GSYNC();
        { pg8::Gemm g{XN, (const bf16_t*)(ws + WS_WGU2), M, NGU, D}; pg8::StaticOrder S; S.init(M, NGU, G, (int)blockIdx.x); pg8::EpiSwiglu E{HB};
          pg8::gemm_phase<pg8::EpiSwiglu, pg8::StaticOrder, true, true>(lds, g, S, E); }
        GSYNC();
        { pg8::Gemm g{HB, (const bf16_t*)(ws + WS_WD2), M, D, DFF}; pg8::StaticOrder S; S.init(M, D, G, (int)blockIdx.x); pg8::EpiResid E{X, ALPHA, beta_half};
          pg8::gemm_phase<pg8::EpiResid, pg8::StaticOrder, true, true>(lds, g, S, E); }
        GSYNC();
        ln_rows(X, a.in[23] + l * D, a.in[24] + l * D, XN);
#ifndef NO_PRO
        if (l + 1 < DEPTH) convert_layer(a, l + 1, lds);
#endif
        GSYNC();
    }
}

extern "C" void kernel_launch(void* const* d_in, const int* in_sizes, int n_in, void* d_out, int out_size, void* d_ws, size_t ws_size, hipStream_t stream) {
    static int grid = 0;
    if (grid == 0) {
        if (n_in != 25 || out_size != M * D || ws_size < WS_END) { fprintf(stderr, "kernel_launch: unexpected shapes (n_in %d out %d ws %zu)\n", n_in, out_size, ws_size); grid = -1; return; }
        int dev = 0, cus = 0, per_cu = 0;
        hipGetDevice(&dev); hipDeviceGetAttribute(&cus, hipDeviceAttributeMultiprocessorCount, dev);
        if (hipFuncSetAttribute((const void*)fwd_megakernel, hipFuncAttributeMaxDynamicSharedMemorySize, LDS_BYTES) != hipSuccess) { fprintf(stderr, "kernel_launch: hipFuncSetAttribute failed\n"); grid = -1; return; }
        if (hipOccupancyMaxActiveBlocksPerMultiprocessor(&per_cu, (const void*)fwd_megakernel, 512, LDS_BYTES) != hipSuccess || per_cu < 1) { fprintf(stderr, "kernel_launch: occupancy query says %d\n", per_cu); per_cu = 1; }
        (void)hipGetLastError();
        grid = cus * per_cu; if (grid > 256) grid = 256;
    }
    if (grid < 0) return;
    if (hipMemsetAsync(d_ws, 0, 65536, stream) != hipSuccess) { fprintf(stderr, "kernel_launch: memset failed\n"); return; }
    Args a{};
    for (int i = 0; i < 25; ++i) a.in[i] = (const float*)d_in[i];
    a.out = (float*)d_out; a.ws = (unsigned char*)d_ws;
    void* args[] = {&a};
    hipError_t e = hipLaunchCooperativeKernel((const void*)fwd_megakernel, dim3(grid), dim3(512), args, LDS_BYTES, stream);
    if (e != hipSuccess) fprintf(stderr, "cooperative launch failed: %s (grid %d)\n", hipGetErrorString(e), grid);
}
```
